# Optimizing an MI355X kernel written in HIP

```python
import jax, jax.numpy as jnp
from jax import lax
import numpy as np

D_MODEL = 2048
BATCH = 1
SEQ = 16384
DEPTH = 1
DEC_BATCH = 8
DEC_SEQ = 2048
PAST_LEN = 128

N_META = 16
GRID_W = 64
EPS = 1e-6
HEAD_DIM = 64
ATT_WIDTH = D_MODEL // 2
N_Q_HEADS = ATT_WIDTH // HEAD_DIM
N_KV_HEADS = 4
Q_PER_KV = N_Q_HEADS // N_KV_HEADS
Q_BLOCK = 128
ROPE_THETA = 10000.0
SSM_WIDTH = D_MODEL - ATT_WIDTH
SSM_HEAD_DIM = 64
N_SSM_HEADS = SSM_WIDTH // SSM_HEAD_DIM
N_SSM_GROUPS = 2
D_STATE = 128
D_CONV = 5
CHUNK = 128
CONV_DIM = SSM_WIDTH + 2 * N_SSM_GROUPS * D_STATE
MIX_WIDTH = ATT_WIDTH + SSM_WIDTH
D_FF = 5632
KV_WIDTH = N_KV_HEADS * HEAD_DIM
IN_PROJ = ATT_WIDTH + 2 * KV_WIDTH + SSM_WIDTH + CONV_DIM + 2 * N_SSM_HEADS
SPLIT_POINTS = [ATT_WIDTH, ATT_WIDTH + KV_WIDTH, ATT_WIDTH + 2 * KV_WIDTH,
                ATT_WIDTH + 2 * KV_WIDTH + SSM_WIDTH,
                ATT_WIDTH + 2 * KV_WIDTH + SSM_WIDTH + CONV_DIM]

kernel_name = "hymba_bidir_attn_ssd_macaron_encoder"


def rms_norm(x, g):
    xf = x.astype(jnp.float32)
    y = xf * lax.rsqrt(jnp.mean(xf * xf, axis=-1, keepdims=True) + EPS)
    return (y * g.astype(jnp.float32)).astype(x.dtype)


def swiglu(u, w_gate, w_up, w_down):
    return (jax.nn.silu(u @ w_gate) * (u @ w_up)) @ w_down


def axial_rope_tables(n_tok):
    rows = n_tok // GRID_W
    row = jnp.repeat(jnp.arange(rows), GRID_W).astype(jnp.float32)
    col = jnp.tile(jnp.arange(GRID_W), rows).astype(jnp.float32)
    n_freq = HEAD_DIM // 4
    inv_freq = ROPE_THETA ** (-jnp.arange(n_freq, dtype=jnp.float32) / n_freq)
    ang = jnp.stack([row[:, None] * inv_freq, col[:, None] * inv_freq], axis=1)
    ang = jnp.broadcast_to(ang[:, :, None, :], (n_tok, 2, 2, n_freq)).reshape(n_tok, HEAD_DIM)
    ang = jnp.concatenate([jnp.zeros((N_META, HEAD_DIM), jnp.float32), ang], axis=0)
    return jnp.cos(ang), jnp.sin(ang)


def apply_axial_rope(x, cos, sin):
    xs = x.reshape(x.shape[:-1] + (2, 2, HEAD_DIM // 4))
    rot = jnp.stack([-xs[..., 1, :], xs[..., 0, :]], axis=-2).reshape(x.shape)
    return x * cos[None, :, None, :] + rot * sin[None, :, None, :]


def attention_group(q, k, v, cos, sin, q_g, k_g):
    b, L = q.shape[:2]
    q = apply_axial_rope(rms_norm(q, q_g).astype(jnp.float32), cos, sin) * (HEAD_DIM ** -0.5)
    k = apply_axial_rope(rms_norm(k, k_g).astype(jnp.float32), cos, sin).astype(v.dtype)
    q = q.astype(v.dtype).reshape(b, L, N_KV_HEADS, Q_PER_KV, HEAD_DIM)

    def attend(qb):
        s = jnp.einsum('bqkgd,bskd->bkgqs', qb, k, preferred_element_type=jnp.float32)
        p = jax.nn.softmax(s, axis=-1).astype(v.dtype)
        return jnp.einsum('bkgqs,bskd->bqkgd', p, v)

    o_meta = attend(q[:, :N_META])
    n_blk = (L - N_META) // Q_BLOCK
    qb = q[:, N_META:].reshape(b, n_blk, Q_BLOCK, N_KV_HEADS, Q_PER_KV, HEAD_DIM).swapaxes(0, 1)
    o = lax.map(attend, qb).swapaxes(0, 1).reshape(b, L - N_META, N_KV_HEADS, Q_PER_KV, HEAD_DIM)
    return jnp.concatenate([o_meta, o], axis=1).reshape(b, L, ATT_WIDTH)


def centred_dwconv(u, w, bias):
    pad = D_CONV // 2
    L = u.shape[1]
    up = jnp.pad(u, ((0, 0), (pad, pad), (0, 0)))
    out = bias
    for j in range(D_CONV):
        out = out + up[:, j:j + L] * w[j]
    return out


def ssd_scan(x, dt, A, Bm, Cm):
    b, l, h, p = x.shape
    g, n = Bm.shape[2], Bm.shape[3]
    r = h // g
    c = l // CHUNK
    xr = (x * dt[..., None]).reshape(b, c, CHUNK, g, r, p)
    a = (dt * A).reshape(b, c, CHUNK, g, r).transpose(0, 3, 4, 1, 2)
    a_cum = jnp.cumsum(a, axis=-1)
    Bc = Bm.reshape(b, c, CHUNK, g, n)
    Cc = Cm.reshape(b, c, CHUNK, g, n)
    causal = jnp.tril(jnp.ones((CHUNK, CHUNK), dtype=bool))
    seg = a_cum[..., :, None] - a_cum[..., None, :]
    Lmat = jnp.exp(jnp.where(causal, seg, -jnp.inf))
    CB = jnp.einsum('bclgn,bcsgn->bcgls', Cc, Bc)
    y_diag = jnp.einsum('bcgls,bgrcls,bcsgrp->bclgrp', CB, Lmat, xr)
    decay_states = jnp.exp(a_cum[..., -1:] - a_cum)
    states = jnp.einsum('bcsgn,bgrcs,bcsgrp->bcgrpn', Bc, decay_states, xr)
    chunk_decay = jnp.exp(a_cum[..., -1])

    def step(carry, inp):
        s_c, d_c = inp
        return carry * d_c[..., None, None] + s_c, carry

    init = jnp.zeros((b, g, r, p, n), jnp.float32)
    _, prev = lax.scan(step, init, (jnp.moveaxis(states, 1, 0), jnp.moveaxis(chunk_decay, -1, 0)))
    prev = jnp.moveaxis(prev, 0, 1)
    y_off = jnp.einsum('bclgn,bcgrpn,bgrcl->bclgrp', Cc, prev, jnp.exp(a_cum))
    return (y_diag + y_off).reshape(b, l, h, p)


def ssd_group(z, xbc, dt_raw, conv_w, conv_b, a_log, dt_bias, d_skip, norm_g):
    b, L = z.shape[:2]
    xbc = jax.nn.silu(centred_dwconv(xbc, conv_w, conv_b)).astype(jnp.float32)
    xs, Bm, Cm = jnp.split(xbc, [SSM_WIDTH, SSM_WIDTH + N_SSM_GROUPS * D_STATE], axis=-1)
    xs = xs.reshape(b, L, N_SSM_HEADS, SSM_HEAD_DIM)
    Bm = Bm.reshape(b, L, N_SSM_GROUPS, D_STATE)
    Cm = Cm.reshape(b, L, N_SSM_GROUPS, D_STATE)
    dt = jax.nn.softplus(dt_raw.astype(jnp.float32).reshape(b, L, 2, N_SSM_HEADS) + dt_bias.astype(jnp.float32))
    A = -jnp.exp(a_log.astype(jnp.float32))
    lead = CHUNK - N_META
    padf = lambda t: jnp.pad(t, ((0, 0), (lead, 0)) + ((0, 0),) * (t.ndim - 2))
    xp, Bp, Cp, dtp = padf(xs), padf(Bm), padf(Cm), padf(dt)
    flip = lambda t: jnp.flip(t, axis=1)
    y_f = ssd_scan(xp, dtp[:, :, 0], A[0], Bp, Cp)
    y_b = flip(ssd_scan(flip(xp), flip(dtp[:, :, 1]), A[1], flip(Bp), flip(Cp)))
    y = (y_f + y_b)[:, lead:] + d_skip.astype(jnp.float32)[:, None] * xs
    y = y.reshape(b, L, SSM_WIDTH) * jax.nn.silu(z.astype(jnp.float32))
    y = rms_norm(y.reshape(b, L, N_SSM_GROUPS, SSM_WIDTH // N_SSM_GROUPS),
                 norm_g.reshape(N_SSM_GROUPS, SSM_WIDTH // N_SSM_GROUPS))
    return y.reshape(b, L, SSM_WIDTH).astype(z.dtype)


def encoder_layer(h, cos, sin, p):
    b, L, _ = h.shape
    u = rms_norm(h, p['ff1_norm_pre'])
    h = h + 0.5 * rms_norm(swiglu(u, p['ff1_w_gate'], p['ff1_w_up'], p['ff1_w_down']), p['ff1_norm_post'])
    u = rms_norm(h, p['mix_norm_pre'])
    q, k, v, z, xbc, dt_raw = jnp.split(u @ p['w_in'], SPLIT_POINTS, axis=-1)
    q = q.reshape(b, L, N_Q_HEADS, HEAD_DIM)
    k = k.reshape(b, L, N_KV_HEADS, HEAD_DIM)
    v = v.reshape(b, L, N_KV_HEADS, HEAD_DIM)
    o_att = attention_group(q, k, v, cos, sin, p['q_norm'], p['k_norm'])
    o_ssm = ssd_group(z, xbc, dt_raw, p['conv_w'], p['conv_b'], p['a_log'], p['dt_bias'], p['d_skip'], p['ssm_norm'])
    mix = jnp.concatenate([o_att, o_ssm], axis=-1) @ p['w_out']
    h = h + rms_norm(mix, p['mix_norm_post'])
    u = rms_norm(h, p['ff2_norm_pre'])
    h = h + 0.5 * rms_norm(swiglu(u, p['ff2_w_gate'], p['ff2_w_up'], p['ff2_w_down']), p['ff2_norm_post'])
    return h


def run_trunk(x, meta_tokens, layers):
    b, n_tok, _ = x.shape
    cos, sin = axial_rope_tables(n_tok)
    meta = jnp.broadcast_to(meta_tokens.astype(x.dtype)[None], (b, N_META, D_MODEL))
    h = jnp.concatenate([meta, x], axis=1)
    for i in range(DEPTH):
        h = encoder_layer(h, cos, sin, {name: w[i] for name, w in layers.items()})
    return h[:, N_META:]


def setup_inputs(seed: int = 0) -> dict:
    key = jax.random.key(seed)
    ks = jax.random.split(key, 32)
    f32 = jnp.float32
    nrm = lambda k, shape, scale: jax.random.normal(k, shape, f32) * scale
    gain = lambda k, shape: 1.0 + 0.05 * jax.random.normal(k, shape, f32)
    dt0 = jnp.exp(jax.random.uniform(ks[12], (DEPTH, 2, N_SSM_HEADS), f32, np.log(1e-3), np.log(1e-1)))
    return {
        'x_prompt': jax.random.normal(ks[0], (BATCH, SEQ, D_MODEL), f32),
        'x_sample': jax.random.normal(ks[1], (DEC_BATCH, DEC_SEQ, D_MODEL), f32),
        'meta_tokens': nrm(ks[2], (N_META, D_MODEL), 1.0),
        'ff1_norm_pre': gain(ks[3], (DEPTH, D_MODEL)),
        'ff1_w_gate': nrm(ks[4], (DEPTH, D_MODEL, D_FF), D_MODEL ** -0.5),
        'ff1_w_up': nrm(ks[5], (DEPTH, D_MODEL, D_FF), D_MODEL ** -0.5),
        'ff1_w_down': nrm(ks[6], (DEPTH, D_FF, D_MODEL), D_FF ** -0.5),
        'ff1_norm_post': gain(ks[7], (DEPTH, D_MODEL)),
        'mix_norm_pre': gain(ks[8], (DEPTH, D_MODEL)),
        'w_in': nrm(ks[9], (DEPTH, D_MODEL, IN_PROJ), D_MODEL ** -0.5),
        'conv_w': nrm(ks[10], (DEPTH, D_CONV, CONV_DIM), D_CONV ** -0.5),
        'conv_b': nrm(ks[11], (DEPTH, CONV_DIM), 0.02),
        'a_log': jnp.log(jax.random.uniform(ks[13], (DEPTH, 2, N_SSM_HEADS), f32, 1.0, 16.0)),
        'dt_bias': dt0 + jnp.log(-jnp.expm1(-dt0)),
        'd_skip': gain(ks[14], (DEPTH, N_SSM_HEADS)),
        'q_norm': gain(ks[15], (DEPTH, HEAD_DIM)),
        'k_norm': gain(ks[16], (DEPTH, HEAD_DIM)),
        'ssm_norm': gain(ks[17], (DEPTH, SSM_WIDTH)),
        'w_out': nrm(ks[18], (DEPTH, MIX_WIDTH, D_MODEL), MIX_WIDTH ** -0.5),
        'mix_norm_post': gain(ks[19], (DEPTH, D_MODEL)),
        'ff2_norm_pre': gain(ks[20], (DEPTH, D_MODEL)),
        'ff2_w_gate': nrm(ks[21], (DEPTH, D_MODEL, D_FF), D_MODEL ** -0.5),
        'ff2_w_up': nrm(ks[22], (DEPTH, D_MODEL, D_FF), D_MODEL ** -0.5),
        'ff2_w_down': nrm(ks[23], (DEPTH, D_FF, D_MODEL), D_FF ** -0.5),
        'ff2_norm_post': gain(ks[24], (DEPTH, D_MODEL)),
    }


def reference(x_prompt, x_sample, meta_tokens, ff1_norm_pre, ff1_w_gate, ff1_w_up, ff1_w_down, ff1_norm_post,
              mix_norm_pre, w_in, conv_w, conv_b, a_log, dt_bias, d_skip, q_norm, k_norm, ssm_norm, w_out,
              mix_norm_post, ff2_norm_pre, ff2_w_gate, ff2_w_up, ff2_w_down, ff2_norm_post):
    layers = {
        'ff1_norm_pre': ff1_norm_pre, 'ff1_w_gate': ff1_w_gate, 'ff1_w_up': ff1_w_up,
        'ff1_w_down': ff1_w_down, 'ff1_norm_post': ff1_norm_post,
        'mix_norm_pre': mix_norm_pre, 'w_in': w_in, 'conv_w': conv_w, 'conv_b': conv_b,
        'a_log': a_log, 'dt_bias': dt_bias, 'd_skip': d_skip, 'q_norm': q_norm, 'k_norm': k_norm,
        'ssm_norm': ssm_norm, 'w_out': w_out, 'mix_norm_post': mix_norm_post,
        'ff2_norm_pre': ff2_norm_pre, 'ff2_w_gate': ff2_w_gate, 'ff2_w_up': ff2_w_up,
        'ff2_w_down': ff2_w_down, 'ff2_norm_post': ff2_norm_post,
    }
    y_prompt = run_trunk(x_prompt, meta_tokens, layers)
    y_sample = run_trunk(x_sample, meta_tokens, layers)
    return (y_prompt, y_sample)
```

```cpp
#include <hip/hip_runtime.h>
#include <hip/hip_cooperative_groups.h>
#include <cstdio>
#include <cstdint>
namespace cg = cooperative_groups;

#define LAS __attribute__((address_space(3)))
#define GAS __attribute__((address_space(1)))
typedef unsigned short bf16_t;
typedef short bf16x8 __attribute__((ext_vector_type(8)));
typedef short s16x4 __attribute__((ext_vector_type(4)));
typedef float f32x4 __attribute__((ext_vector_type(4)));
typedef float f32x16 __attribute__((ext_vector_type(16)));
typedef unsigned u32x4 __attribute__((ext_vector_type(4)));
typedef unsigned u32x2 __attribute__((ext_vector_type(2)));

constexpr int DM = 2048, FF = 5632, NTOKR = 32768, NSEQ = 9, ROWS = NTOKR + NSEQ * 16  , ROWSP = 33024  ;
constexpr int NINP = 4352;
constexpr int NCHUNK = 265;
constexpr float EPS = 1e-6f;
constexpr float QSCALE = 0.125f * 1.4426950408889634f;
constexpr int KVPOS = 16512 + 8 * 2176;

constexpr size_t SZ_WIN = (size_t)NINP * DM * 2, SZ_WOUT = (size_t)DM * DM * 2, SZ_GU = (size_t)2 * FF * DM * 2, SZ_DN = (size_t)DM * FF * 2;
constexpr size_t OFF_WIN = 0, OFF_WOUT = OFF_WIN + SZ_WIN, OFF_GU1 = OFF_WOUT + SZ_WOUT, OFF_DN1 = OFF_GU1 + SZ_GU, OFF_GU2 = OFF_DN1 + SZ_DN, OFF_DN2 = OFF_GU2 + SZ_GU;
constexpr size_t OFF_STATES = OFF_GU1, SZ_STATES = (size_t)NCHUNK * 32 * 8192 * 2;
constexpr size_t OFF_MISC = ((OFF_STATES + SZ_STATES > OFF_DN2 + SZ_DN ? OFF_STATES + SZ_STATES : OFF_DN2 + SZ_DN) + 255) & ~(size_t)255;
constexpr size_t OFF_CTL = OFF_MISC, OFF_HMETA = OFF_CTL + 4096, OFF_DEC = OFF_HMETA + (size_t)144 * DM * 4, OFF_RSTD = OFF_DEC + (size_t)NCHUNK * 32 * 4 + 128,
                 OFF_DT = OFF_RSTD + (size_t)ROWSP * 2 * 4, OFF_B = OFF_DT + (size_t)ROWSP * 32 * 4;
constexpr size_t SZ_B = (size_t)ROWSP * DM * 2;
constexpr size_t OFF_C = OFF_B + SZ_B;
constexpr size_t OFF_Q = OFF_C, OFF_Z = OFF_Q + (size_t)ROWSP * 1024 * 2, OFF_XBC = OFF_Z + (size_t)ROWSP * 1024 * 2, OFF_KP = OFF_XBC + (size_t)ROWSP * 1536 * 2,
                 OFF_VT = OFF_KP + (size_t)KVPOS * 256 * 2, OFF_END = OFF_VT + (size_t)KVPOS * 256 * 2;
constexpr size_t OFF_HID = OFF_C, OFF_MO = OFF_C;
constexpr size_t OFF_BAR = OFF_RSTD;
static_assert((size_t)3456 * 4 <= (size_t)ROWSP * 2 * 4 && OFF_RSTD % 256 == 0, "barrier words");
static_assert((size_t)16640 * FF * 2 <= OFF_END - OFF_C, "hidden overlay");
static_assert(OFF_END <= 596000000ull, "workspace budget");
static_assert(OFF_MISC % 256 == 0 && OFF_B % 256 == 0 && OFF_DT % 16 == 0 && OFF_RSTD % 8 == 0, "align");

constexpr int LDS_BYTES = 136 * 1024;
constexpr int MISC_LDS = 131072;

struct Params { const float* in[25]; float* out; unsigned char* ws; int ph_lo, ph_hi; };

__device__ __forceinline__ unsigned f2bf(float f) { unsigned u = __builtin_bit_cast(unsigned, f); return (u + 0x7fffu + ((u >> 16) & 1u)) >> 16; }
__device__ __forceinline__ unsigned pk2(float lo, float hi) { return f2bf(lo) | (f2bf(hi) << 16); }
__device__ __forceinline__ float bf2f(bf16_t b) { return __builtin_bit_cast(float, (unsigned)b << 16); }
__device__ __forceinline__ float bflo(unsigned u) { return __builtin_bit_cast(float, u << 16); }
__device__ __forceinline__ float bfhi(unsigned u) { return __builtin_bit_cast(float, u & 0xffff0000u); }
__device__ __forceinline__ unsigned cvt_pk_bf16(float lo, float hi) { unsigned r; asm volatile("v_cvt_pk_bf16_f32 %0, %1, %2" : "=v"(r) : "v"(lo), "v"(hi)); return r; }
__device__ __forceinline__ float wave_sum(float v) {
#pragma unroll
    for (int o = 1; o < 64; o <<= 1) v += __shfl_xor(v, o);
    return v;
}
__device__ __forceinline__ float silu_f(float x) { return x * __builtin_amdgcn_rcpf(1.f + __expf(-x)); }
#define LDS_WAIT() asm volatile("s_waitcnt lgkmcnt(0)" ::: "memory")
__device__ __forceinline__ float shfl_up_l(float v, int o, int lane) { int src = lane - o; src = src < 0 ? lane : src; return __builtin_bit_cast(float, __builtin_amdgcn_ds_bpermute(src << 2, __builtin_bit_cast(int, v))); }
__device__ __forceinline__ float shfl_idx_l(float v, int src) { return __builtin_bit_cast(float, __builtin_amdgcn_ds_bpermute(src << 2, __builtin_bit_cast(int, v))); }

__device__ __forceinline__ int seq_base(int s) { return s == 0 ? 0 : 16384 + (s - 1) * 2048; }
__device__ __forceinline__ int seq_L(int s) { return s == 0 ? 16400 : 2064; }
__device__ __forceinline__ int seq_Lpad(int s) { return s == 0 ? 16512 : 2176; }
__device__ __forceinline__ int seq_koff(int s) { return s == 0 ? 0 : 16512 + (s - 1) * 2176; }
__device__ __forceinline__ int pos2row(int s, int pos) { return pos < 16 ? NTOKR + 16 * s + pos : seq_base(s) + pos - 16; }
__device__ __forceinline__ void row2sp(int r, int& s, int& pos) {
    if (r < 16384) { s = 0; pos = r + 16; }
    else if (r < NTOKR) { const int q = r - 16384; s = 1 + (q >> 11); pos = (q & 2047) + 16; }
    else { const int q = r - NTOKR; s = q >> 4; pos = q & 15; }
}
__device__ __forceinline__ const float* h0row(const Params& p, int r) {
    return r < 16384 ? p.in[0] + (size_t)r * DM : (r < NTOKR ? p.in[1] + (size_t)(r - 16384) * DM : p.in[2] + (size_t)((r - NTOKR) & 15) * DM);
}
__device__ __forceinline__ float* hrow(const Params& p, int r) {
    return r < NTOKR ? p.out + (size_t)r * DM : (float*)(p.ws + OFF_HMETA) + (size_t)(r - NTOKR) * DM;
}

namespace pg8 {
constexpr int BM = 256, BK = 64, HALF = 128, HTB = HALF * BK * 2, STAGE_BYTES = 8 * HTB, NXCD = 8, WGM = 8;
__device__ __forceinline__ int lds_byte(int r, int c) { const int st = (r >> 4) * 2 + (c >> 5), rr = r & 15, cc = c & 31, ob = rr * 64 + cc * 2; return st * 1024 + (ob ^ (((ob >> 9) & 1) << 5)); }
__device__ __forceinline__ void stage_rc(int b, int& R, int& C) { const int st = b / 1024, sb = b % 1024, swz = sb ^ (((sb >> 9) & 1) << 5); R = (st >> 1) * 16 + swz / 64; C = (st & 1) * 32 + (swz % 64) / 2; }
__device__ __forceinline__ int perm32(int rho) { const int n = rho >> 4, i = rho & 15; return 8 * (i >> 2) + 4 * n + (i & 3); }
struct Unit { int pm, pn; };
struct Gemm { const bf16_t* A; const bf16_t* Bt; int M, N, K; };
struct StaticOrder {
    int nM, nN, nwg, G, c;
    __device__ void init(int M, int N, int G_, int c_) { nM = M / BM; nN = N / BM; nwg = nM * nN; G = G_; c = c_; }
    __device__ bool next(int i, Unit& u) const {
        const long L = (long)i * G + c; if (L >= nwg) return false;
        int wgid = (int)L; { const int q = nwg / NXCD, r = nwg % NXCD, xcd = wgid % NXCD, off = wgid / NXCD; wgid = (xcd < r ? xcd * (q + 1) : r * (q + 1) + (xcd - r) * q) + off; }
        const int nig = WGM * nN, gid = wgid / nig, fm = gid * WGM, gsz = (nM - fm) < WGM ? (nM - fm) : WGM;
        u.pm = fm + ((wgid % nig) % gsz); u.pn = (wgid % nig) / gsz; return true;
    }
};
template <class Epi>
__device__ __forceinline__ void gemm_phase(LAS unsigned char* lds, const Gemm g, const StaticOrder& S, const Epi& E, const int tid) {
    const int wid = __builtin_amdgcn_readfirstlane(tid >> 6), lane = tid & 63, wr = wid >> 2, wc = wid & 3, fr = lane & 15, fq = lane >> 4;
    const int K = g.K, nt = K / BK;
    unsigned voffA[2], voffB[2];
#pragma unroll
    for (int i = 0; i < 2; ++i) { int R, C; stage_rc(tid * 16 + i * 8192, R, C); const int Rb = (R & ~31) + perm32(R & 31);
        voffA[i] = (unsigned)(R * K + C) * 2u; voffB[i] = (unsigned)(Rb * K + C) * 2u; }
    const size_t kstep = (size_t)(BK * 2);
    const size_t hstep = (size_t)HALF * K * 2;
    const size_t tstep = 2 * hstep;
    const unsigned ldsw = (unsigned)wid * 1024u;
    const int aoff = lds_byte(wr * 64 + fr, fq * 8), boff = lds_byte(wc * 32 + fr, fq * 8);
#define PG8_SA(b, h) (((b) * 2 + (h)) * HTB)
#define PG8_SB(b, h) ((4 + (b) * 2 + (h)) * HTB)
#define PG8_STAGE(bufoff, gbase, voff) do { _Pragma("unroll") for (int _i = 0; _i < 2; ++_i) \
        __builtin_amdgcn_global_load_lds((const unsigned*)((const char*)(gbase) + (voff)[_i]), (LAS unsigned*)(lds + (bufoff) + ldsw + _i * 8192), 16, 0, 0); } while (0)
#define PG8_LDA(dst, b, h) do { _Pragma("unroll") for (int m = 0; m < 4; ++m) _Pragma("unroll") for (int k = 0; k < 2; ++k) dst[m][k] = *(const LAS bf16x8*)(lds + PG8_SA(b, h) + aoff + m * 2048 + k * 1024); } while (0)
#define PG8_LDB(dst, b, h) do { _Pragma("unroll") for (int n = 0; n < 2; ++n) _Pragma("unroll") for (int k = 0; k < 2; ++k) dst[n][k] = *(const LAS bf16x8*)(lds + PG8_SB(b, h) + boff + n * 2048 + k * 1024); } while (0)
#define PG8_MMA(ai, bj, At, Bt) do { __builtin_amdgcn_s_setprio(1); _Pragma("unroll") for (int m = 0; m < 4; ++m) _Pragma("unroll") for (int n = 0; n < 2; ++n) _Pragma("unroll") for (int k = 0; k < 2; ++k) \
        acc[ai][bj][m][n] = __builtin_amdgcn_mfma_f32_16x16x32_bf16(Bt[n][k], At[m][k], acc[ai][bj][m][n], 0, 0, 0); __builtin_amdgcn_s_setprio(0); } while (0)
#define PG8_WAIT_V(n) asm volatile("s_waitcnt vmcnt(" #n ")" ::: "memory")
#define PG8_WAIT_L(n) asm volatile("s_waitcnt lgkmcnt(" #n ")" ::: "memory")
#define PG8_BAR __builtin_amdgcn_s_barrier()
#define PG8_SCHED __builtin_amdgcn_sched_barrier(0)
    Unit cur, nxt; int ui = 0;
    if (!S.next(0, cur)) return;
    f32x4 acc[2][2][4][2];
#pragma unroll
    for (int a = 0; a < 2; ++a)
#pragma unroll
        for (int b = 0; b < 2; ++b)
#pragma unroll
            for (int m = 0; m < 4; ++m)
#pragma unroll
                for (int n = 0; n < 2; ++n) acc[a][b][m][n] = (f32x4){0.f, 0.f, 0.f, 0.f};
    bf16x8 At[4][2], B0[2][2], B1[2][2];
    const char* cA = (const char*)g.A + (size_t)cur.pm * tstep; const char* cB = (const char*)g.Bt + (size_t)cur.pn * tstep;
    PG8_STAGE(PG8_SB(0, 0), cB, voffB); PG8_STAGE(PG8_SB(0, 1), cB + hstep, voffB); PG8_STAGE(PG8_SA(0, 0), cA, voffA); PG8_STAGE(PG8_SA(0, 1), cA + hstep, voffA);
    if (wr == 1) PG8_BAR;
    PG8_WAIT_V(2); PG8_BAR;
    PG8_STAGE(PG8_SB(1, 0), cB + kstep, voffB); PG8_STAGE(PG8_SA(1, 0), cA + kstep, voffA); PG8_STAGE(PG8_SB(1, 1), cB + hstep + kstep, voffB);
    PG8_WAIT_V(6); PG8_BAR;
    for (;;) {
        const bool has_next = S.next(ui + 1, nxt);
        const char* nA = has_next ? (const char*)g.A + (size_t)nxt.pm * tstep : cA; const char* nB = has_next ? (const char*)g.Bt + (size_t)nxt.pn * tstep : cB;
        for (int t = 0; t < nt; t += 2) {
            const bool last = (t == nt - 2);
            const char* a1 = cA + (size_t)(t + 1) * kstep;
            const char* a2 = last ? nA : cA + (size_t)(t + 2) * kstep; const char* b2 = last ? nB : cB + (size_t)(t + 2) * kstep;
            const char* a3 = a2 + kstep; const char* b3 = b2 + kstep;
            PG8_LDB(B0, 0, 0); PG8_LDB(B1, 0, 1); PG8_SCHED; PG8_LDA(At, 0, 0); PG8_STAGE(PG8_SA(1, 1), a1 + hstep, voffA);
            PG8_WAIT_V(8); PG8_WAIT_L(0); PG8_BAR; PG8_MMA(0, 0, At, B0); PG8_MMA(0, 1, At, B1); PG8_BAR; PG8_SCHED;
            PG8_LDA(At, 0, 1); PG8_STAGE(PG8_SB(0, 0), b2, voffB); PG8_STAGE(PG8_SB(0, 1), b2 + hstep, voffB); PG8_STAGE(PG8_SA(0, 0), a2, voffA);
            PG8_WAIT_V(8); PG8_WAIT_L(0); PG8_BAR; PG8_MMA(1, 0, At, B0); PG8_MMA(1, 1, At, B1); PG8_BAR; PG8_SCHED;
            PG8_LDB(B0, 1, 0); PG8_LDB(B1, 1, 1); PG8_SCHED; PG8_LDA(At, 1, 0); PG8_STAGE(PG8_SA(0, 1), a2 + hstep, voffA);
            PG8_WAIT_V(8); PG8_WAIT_L(0); PG8_BAR; PG8_MMA(0, 0, At, B0); PG8_MMA(0, 1, At, B1); PG8_BAR; PG8_SCHED;
            PG8_LDA(At, 1, 1); PG8_STAGE(PG8_SB(1, 0), b3, voffB); PG8_STAGE(PG8_SB(1, 1), b3 + hstep, voffB); PG8_STAGE(PG8_SA(1, 0), a3, voffA);
            PG8_WAIT_V(8); PG8_WAIT_L(0); PG8_BAR; PG8_MMA(1, 0, At, B0); PG8_MMA(1, 1, At, B1); PG8_BAR; PG8_SCHED;
        }
        if (wr == 0) PG8_BAR;
        E(acc, cur, wr, wc, fr, fq);
        if (!has_next) break;
#pragma unroll
        for (int a = 0; a < 2; ++a)
#pragma unroll
            for (int b = 0; b < 2; ++b)
#pragma unroll
                for (int m = 0; m < 4; ++m)
#pragma unroll
                    for (int n = 0; n < 2; ++n) acc[a][b][m][n] = (f32x4){0.f, 0.f, 0.f, 0.f};
        cur = nxt; cA = nA; cB = nB; ++ui;
        if (wr == 1) PG8_BAR;
    }
    PG8_WAIT_V(0);
    PG8_BAR;
#undef PG8_SA
#undef PG8_SB
#undef PG8_STAGE
#undef PG8_LDA
#undef PG8_LDB
#undef PG8_MMA
#undef PG8_WAIT_V
#undef PG8_WAIT_L
#undef PG8_BAR
#undef PG8_SCHED
}

struct EpiStore {
    bf16_t* O; int ldc;
    __device__ __forceinline__ void operator()(const f32x4 (&acc)[2][2][4][2], const Unit& u, int wr, int wc, int fr, int fq) const {
        const int row0 = u.pm * BM + wr * 64 + fr, col0 = u.pn * BM + wc * 32 + 8 * fq;
#pragma unroll
        for (int ai = 0; ai < 2; ++ai)
#pragma unroll
            for (int m = 0; m < 4; ++m) { bf16_t* rowp = O + (size_t)(row0 + ai * HALF + m * 16) * ldc + col0;
#pragma unroll
                for (int bj = 0; bj < 2; ++bj) { const f32x4 v0 = acc[ai][bj][m][0], v1 = acc[ai][bj][m][1];
                    u32x4 w; w.x = cvt_pk_bf16(v0[0], v0[1]); w.y = cvt_pk_bf16(v0[2], v0[3]); w.z = cvt_pk_bf16(v1[0], v1[1]); w.w = cvt_pk_bf16(v1[2], v1[3]);
                    *(u32x4*)(rowp + bj * HALF) = w; } }
    }
};
struct EpiSwiglu {
    bf16_t* O;
    __device__ __forceinline__ void operator()(const f32x4 (&acc)[2][2][4][2], const Unit& u, int wr, int wc, int fr, int fq) const {
        const int row0 = u.pm * BM + wr * 64 + fr, col0 = u.pn * HALF + wc * 32 + 8 * fq;
#pragma unroll
        for (int ai = 0; ai < 2; ++ai)
#pragma unroll
            for (int m = 0; m < 4; ++m) { bf16_t* rowp = O + (size_t)(row0 + ai * HALF + m * 16) * FF + col0;
                float o[8];
#pragma unroll
                for (int n = 0; n < 2; ++n)
#pragma unroll
                    for (int i = 0; i < 4; ++i) { const float gt = acc[ai][0][m][n][i], up = acc[ai][1][m][n][i]; o[4 * n + i] = silu_f(gt) * up; }
                u32x4 w; w.x = cvt_pk_bf16(o[0], o[1]); w.y = cvt_pk_bf16(o[2], o[3]); w.z = cvt_pk_bf16(o[4], o[5]); w.w = cvt_pk_bf16(o[6], o[7]);
                *(u32x4*)rowp = w; }
    }
};
struct EpiInproj {
    bf16_t *Q, *KP, *VT, *Z, *XBC; float* DT; const float* dt_bias;
    __device__ __forceinline__ void operator()(const f32x4 (&acc)[2][2][4][2], const Unit& u, int wr, int wc, int fr, int fq) const {
        const int pn = u.pn, row0 = u.pm * BM + wr * 64 + fr, c0 = wc * 32 + 8 * fq;
        if (pn == 4 || pn == 5) {
#pragma unroll
            for (int ai = 0; ai < 2; ++ai)
#pragma unroll
                for (int m = 0; m < 4; ++m) {
                    int r = row0 + ai * HALF + m * 16; asm volatile("" : "+v"(r));
                    if (r < ROWS) {
                        int s, pos; row2sp(r, s, pos); const unsigned Lp = (unsigned)seq_Lpad(s), kb = (unsigned)seq_koff(s) * 4u;
#pragma unroll
                        for (int bj = 0; bj < 2; ++bj) { const f32x4 v0 = acc[ai][bj][m][0], v1 = acc[ai][bj][m][1];
                            const unsigned c = (unsigned)(bj * HALF + c0), kvh = c >> 6, d = c & 63u;
                            if (pn == 4) { u32x4 w; w.x = cvt_pk_bf16(v0[0], v0[1]); w.y = cvt_pk_bf16(v0[2], v0[3]); w.z = cvt_pk_bf16(v1[0], v1[1]); w.w = cvt_pk_bf16(v1[2], v1[3]);
                                *(u32x4*)(KP + (size_t)((kb + kvh * Lp + (unsigned)pos) * 64u + d)) = w; }
                            else { unsigned vo = kb * 64u + (kvh * 64u + d) * Lp + (unsigned)pos;
#pragma unroll
                                for (int i = 0; i < 4; ++i) { VT[vo] = (bf16_t)f2bf(v0[i]); vo += Lp; }
#pragma unroll
                                for (int i = 0; i < 4; ++i) { VT[vo] = (bf16_t)f2bf(v1[i]); vo += Lp; } } }
                    }
                    __builtin_amdgcn_sched_barrier(0);
                }
        } else if (pn == 16) {
            if (wc == 0) {
#pragma unroll
                for (int ai = 0; ai < 2; ++ai)
#pragma unroll
                    for (int m = 0; m < 4; ++m) { const int r = row0 + ai * HALF + m * 16;
                        const f32x4 v0 = acc[ai][0][m][0], v1 = acc[ai][0][m][1]; float* dp = DT + (size_t)r * 32 + c0;
#pragma unroll
                        for (int i = 0; i < 4; ++i) { float x0 = v0[i] + dt_bias[c0 + i], x1 = v1[i] + dt_bias[c0 + 4 + i];
                            dp[i] = x0 > 20.f ? x0 : log1pf(__expf(x0)); dp[4 + i] = x1 > 20.f ? x1 : log1pf(__expf(x1)); }
                        __builtin_amdgcn_sched_barrier(0); }
            }
        } else {
            bf16_t* base; int ld, ct;
            if (pn < 4) { base = Q; ld = 1024; ct = pn; } else if (pn < 10) { base = Z; ld = 1024; ct = pn - 6; } else { base = XBC; ld = 1536; ct = pn - 10; }
            base += ct * BM + c0;
#pragma unroll
            for (int ai = 0; ai < 2; ++ai)
#pragma unroll
                for (int m = 0; m < 4; ++m) { bf16_t* rowp = base + (size_t)(row0 + ai * HALF + m * 16) * ld;
#pragma unroll
                    for (int bj = 0; bj < 2; ++bj) { const f32x4 v0 = acc[ai][bj][m][0], v1 = acc[ai][bj][m][1];
                        u32x4 w; w.x = cvt_pk_bf16(v0[0], v0[1]); w.y = cvt_pk_bf16(v0[2], v0[3]); w.z = cvt_pk_bf16(v1[0], v1[1]); w.w = cvt_pk_bf16(v1[2], v1[3]);
                        *(u32x4*)(rowp + bj * HALF) = w; } }
        }
    }
};
}

__device__ __forceinline__ void transpose_item(const float* W, int K, int N, bf16_t* WT, int drow0, int k0, int n0, LAS float* scr, int lane) {
#pragma unroll
    for (int i = 0; i < 32; ++i) { const int kk = 2 * i + (lane >> 5); scr[kk * 33 + (lane & 31)] = __builtin_nontemporal_load(&W[(size_t)(k0 + kk) * N + n0 + (lane & 31)]); }
    LDS_WAIT();
    const int c = lane & 7;
#pragma unroll
    for (int j = 0; j < 4; ++j) { const int n = (lane >> 3) + 8 * j; const LAS float* s = scr + (8 * c) * 33 + n;
        u32x4 o; o.x = pk2(s[0 * 33], s[1 * 33]); o.y = pk2(s[2 * 33], s[3 * 33]); o.z = pk2(s[4 * 33], s[5 * 33]); o.w = pk2(s[6 * 33], s[7 * 33]);
        *(u32x4*)(WT + (size_t)(drow0 + n) * K + k0 + 8 * c) = o; }
    LDS_WAIT();
}
__device__ __forceinline__ void convert_ffn(const float* Wg, const float* Wu, const float* Wd, bf16_t* GU, bf16_t* DN, LAS float* scr, int gw, int NGW, int lane) {
    constexpr int I1 = (DM / 64) * (FF / 32);
    for (int it = gw; it < 3 * I1; it += NGW) {
        if (it < 2 * I1) { const int up = it >= I1, r = it - up * I1, kb = r / (FF / 32), nb = r % (FF / 32), n0 = nb * 32;
            transpose_item(up ? Wu : Wg, DM, FF, GU, 256 * (n0 >> 7) + up * 128 + (n0 & 127), kb * 64, n0, scr, lane); }
        else { const int r = it - 2 * I1, kb = r / (DM / 32), nb = r % (DM / 32); transpose_item(Wd, FF, DM, DN, nb * 32, kb * 64, nb * 32, scr, lane); }
    }
}

__device__ __forceinline__ void convert_ffn_dyn(const float* Wg, const float* Wu, const float* Wd, bf16_t* GU, bf16_t* DN, LAS unsigned char* lds, unsigned* ctr, int max_batches, int tid, int wave, int lane) {
    constexpr int I1 = (DM / 64) * (FF / 32), NB = 3 * I1 / 8;
    LAS int* MISC = (LAS int*)(lds + MISC_LDS); LAS float* scr = (LAS float*)(lds + wave * 16384);
    for (int n = 0; n < max_batches; ++n) {
        if (tid == 0) MISC[0] = (int)atomicAdd(ctr, 1u);
        __syncthreads();
        const int b = __builtin_amdgcn_readfirstlane(MISC[0]);
        __syncthreads();
        if (b >= NB) break;
        const int it = b * 8 + wave;
        if (it < 2 * I1) { const int up = it >= I1, r = it - up * I1, kb = r / (FF / 32), nb = r % (FF / 32), n0 = nb * 32;
            transpose_item(up ? Wu : Wg, DM, FF, GU, 256 * (n0 >> 7) + up * 128 + (n0 & 127), kb * 64, n0, scr, lane); }
        else { const int r = it - 2 * I1, kb = r / (DM / 32), nb = r % (DM / 32); transpose_item(Wd, FF, DM, DN, nb * 32, kb * 64, nb * 32, scr, lane); }
    }
}

template <int MODE>
__device__ __forceinline__ void row_load(const Params& p, int r, int lane, const bf16_t* Dsrc, f32x4 (&h)[8], u32x2 (&dw)[8]) {
    if (r >= ROWS || (MODE >= 2 && r >= NTOKR)) return;
    const f32x4* hs = (const f32x4*)((MODE <= 1) ? h0row(p, r) : (const float*)hrow(p, r));
#pragma unroll
    for (int j = 0; j < 8; ++j) h[j] = __builtin_nontemporal_load(&hs[lane + 64 * j]);
    if (MODE >= 1) { const u32x2* dp = (const u32x2*)(Dsrc + (size_t)r * DM);
#pragma unroll
        for (int j = 0; j < 8; ++j) dw[j] = __builtin_nontemporal_load(&dp[lane + 64 * j]); }
}
template <int MODE>
__device__ __forceinline__ void row_finish(const Params& p, int r, int lane, const float* gpost, const float* gnext, bf16_t* U, float coef, f32x4 (&h)[8], const u32x2 (&dw)[8]) {
    if (r >= ROWSP) return;
    if (r >= ROWS) { if (MODE != 3) { u32x4* up = (u32x4*)(U + (size_t)r * DM);
#pragma unroll
            for (int j = 0; j < 4; ++j) up[lane + 64 * j] = (u32x4){0u, 0u, 0u, 0u}; } return; }
    if (MODE >= 2 && r >= NTOKR) return;
    if (MODE >= 1) {
        f32x4 d[8]; float ss = 0.f;
#pragma unroll
        for (int j = 0; j < 8; ++j) { const u32x2 w = dw[j]; d[j] = (f32x4){bflo(w.x), bfhi(w.x), bflo(w.y), bfhi(w.y)};
            ss += (d[j].x * d[j].x + d[j].y * d[j].y) + (d[j].z * d[j].z + d[j].w * d[j].w); }
        ss = wave_sum(ss);
        const float rs = rsqrtf(ss * (1.f / DM) + EPS) * coef;
        f32x4* hd = (f32x4*)hrow(p, r);
#pragma unroll
        for (int j = 0; j < 8; ++j) { const f32x4 g = ((const f32x4*)gpost)[lane + 64 * j]; h[j] = h[j] + d[j] * g * rs; if (r < NTOKR) __builtin_nontemporal_store(h[j], &hd[lane + 64 * j]); }
    }
    if (MODE != 3) {
        float s2 = 0.f;
#pragma unroll
        for (int j = 0; j < 8; ++j) s2 += (h[j].x * h[j].x + h[j].y * h[j].y) + (h[j].z * h[j].z + h[j].w * h[j].w);
        s2 = wave_sum(s2);
        const float rs2 = rsqrtf(s2 * (1.f / DM) + EPS);
        u32x2* up = (u32x2*)(U + (size_t)r * DM);
#pragma unroll
        for (int j = 0; j < 8; ++j) { const f32x4 g = ((const f32x4*)gnext)[lane + 64 * j]; const f32x4 v = h[j] * g * rs2;
            u32x2 w; w.x = pk2(v.x, v.y); w.y = pk2(v.z, v.w); up[lane + 64 * j] = w; }
    }
}
template <int MODE>
__device__ __forceinline__ void row_pass(const Params& p, int wave, int lane, const float* gpost, const float* gnext, const bf16_t* Dsrc, bf16_t* U, float coef, int rbeg) {
    const int gw = blockIdx.x * 8 + wave, NGW = gridDim.x * 8;
    for (int r = rbeg + gw; r < ROWSP; r += 2 * NGW) {
        f32x4 ha[8], hb[8]; u32x2 da[8], db[8];
        row_load<MODE>(p, r, lane, Dsrc, ha, da);
        row_load<MODE>(p, r + NGW, lane, Dsrc, hb, db);
        row_finish<MODE>(p, r, lane, gpost, gnext, U, coef, ha, da);
        row_finish<MODE>(p, r + NGW, lane, gpost, gnext, U, coef, hb, db);
    }
}
constexpr int RP_CHUNKS = 16384 / 64;
template <int MODE>
__device__ __forceinline__ void row_pass_chunks(const Params& p, LAS int* MISC, unsigned* ctr, int max_chunks, int tid, int wave, int lane, const float* gpost, const float* gnext, const bf16_t* Dsrc, bf16_t* U, float coef, int chunk0 = 0) {
    for (int n = 0; n < max_chunks; ++n) {
        if (tid == 0) MISC[0] = (int)atomicAdd(ctr, 1u);
        __syncthreads();
        const int c = __builtin_amdgcn_readfirstlane(MISC[0]);
        __syncthreads();
        if (c >= RP_CHUNKS) break;
        const int r0 = (chunk0 + c) * 64 + wave * 8;
#pragma unroll 1
        for (int k = 0; k < 8; k += 2) {
            f32x4 ha[8], hb[8]; u32x2 da[8], db[8];
            row_load<MODE>(p, r0 + k, lane, Dsrc, ha, da);
            row_load<MODE>(p, r0 + k + 1, lane, Dsrc, hb, db);
            row_finish<MODE>(p, r0 + k, lane, gpost, gnext, U, coef, ha, da);
            row_finish<MODE>(p, r0 + k + 1, lane, gpost, gnext, U, coef, hb, db);
        }
    }
}

__device__ __forceinline__ void prep_vec(bf16_t* vp, int j, const float* gain, const float (&cs)[8], const float (&sn)[8], float scale) {
    u32x2 w[4]; float x[16];
#pragma unroll
    for (int q = 0; q < 4; ++q) { w[q] = *(const u32x2*)(vp + 16 * q + 4 * j); x[4 * q] = bflo(w[q].x); x[4 * q + 1] = bfhi(w[q].x); x[4 * q + 2] = bflo(w[q].y); x[4 * q + 3] = bfhi(w[q].y); }
    float ss = 0.f;
#pragma unroll
    for (int i = 0; i < 16; ++i) ss += x[i] * x[i];
    ss += __shfl_xor(ss, 1); ss += __shfl_xor(ss, 2);
    const float rs = rsqrtf(ss * (1.f / 64.f) + EPS);
#pragma unroll
    for (int q = 0; q < 4; ++q) { const f32x4 g = *(const f32x4*)(gain + 16 * q + 4 * j);
        x[4 * q] *= rs * g.x; x[4 * q + 1] *= rs * g.y; x[4 * q + 2] *= rs * g.z; x[4 * q + 3] *= rs * g.w; }
    float o[16];
#pragma unroll
    for (int ax = 0; ax < 2; ++ax)
#pragma unroll
        for (int i = 0; i < 4; ++i) { const float a = x[8 * ax + i], b = x[8 * ax + 4 + i], c = cs[4 * ax + i], s_ = sn[4 * ax + i];
            o[8 * ax + i] = (a * c - b * s_) * scale; o[8 * ax + 4 + i] = (b * c + a * s_) * scale; }
#pragma unroll
    for (int q = 0; q < 4; ++q) { u32x2 r; r.x = pk2(o[4 * q], o[4 * q + 1]); r.y = pk2(o[4 * q + 2], o[4 * q + 3]); *(u32x2*)(vp + 16 * q + 4 * j) = r; }
}
constexpr int PREP_CHUNK = 64, PREP_NCHUNK = (ROWS + PREP_CHUNK - 1) / PREP_CHUNK;
__device__ __forceinline__ void prep_rows(const Params& p, int chunk, int wave, int lane) {
    bf16_t* Q = (bf16_t*)(p.ws + OFF_Q); bf16_t* KP = (bf16_t*)(p.ws + OFF_KP);
    const int j = lane & 3, hl = lane >> 2;
    float invf[4];
#pragma unroll
    for (int i = 0; i < 4; ++i) invf[i] = exp2f(-(float)(4 * j + i) * (13.287712379549449f / 16.f));
    for (int k = 0; k < PREP_CHUNK / 8; ++k) {
        const int r = chunk * PREP_CHUNK + k * 8 + wave;
        if (r >= ROWS) break;
        int s, pos; row2sp(r, s, pos);
        float cs[8], sn[8];
#pragma unroll
        for (int i = 0; i < 8; ++i) { cs[i] = 1.f; sn[i] = 0.f; }
        if (pos >= 16) { const int ti = pos - 16; const float fr = (float)(ti >> 6), fc = (float)(ti & 63);
#pragma unroll
            for (int i = 0; i < 4; ++i) { const float a0 = fr * invf[i], a1 = fc * invf[i]; cs[i] = __cosf(a0); sn[i] = __sinf(a0); cs[4 + i] = __cosf(a1); sn[4 + i] = __sinf(a1); } }
        if (r < NTOKR) prep_vec(Q + (size_t)r * 1024 + hl * 64, j, p.in[15], cs, sn, QSCALE);
        if (hl < 4) { const int Lp = seq_Lpad(s); prep_vec(KP + ((size_t)seq_koff(s) * 4 + (size_t)hl * Lp + pos) * 64, j, p.in[16], cs, sn, 1.f); }
    }
}
__device__ __forceinline__ void prep_pads(const Params& p, int tid) {
    bf16_t* KP = (bf16_t*)(p.ws + OFF_KP); bf16_t* VT = (bf16_t*)(p.ws + OFF_VT);
    const int gt = blockIdx.x * 512 + tid, NT = gridDim.x * 512;
    for (int i = gt; i < NSEQ * 4 * 112 * 64; i += NT) {
        const int d = i & 63, q = i >> 6, pp = q % 112, sh = q / 112, s = sh >> 2, kvh = sh & 3;
        const int L = seq_L(s), Lp = seq_Lpad(s); const size_t kb = (size_t)seq_koff(s) * 4;
        KP[(kb + (size_t)kvh * Lp + L + pp) * 64 + d] = 0;
        VT[kb * 64 + (size_t)(kvh * 64 + d) * Lp + L + pp] = 0;
    }
}

constexpr int ATT_BIG = 512, ATT_UNITS = ATT_BIG + 16 + 1152;
constexpr int KPITCH = 72;
constexpr int VPITCH = 136;
__device__ __forceinline__ void attn_unit(unsigned char* ws, LAS unsigned char* lds, int s, int kvh, int qb, int hq, int nblk, int tid, int wave, int lane, const int FAST) {
    const int h = kvh * 4 + hq, L = seq_L(s), Lp = seq_Lpad(s), ntile = Lp >> 7;
    const GAS bf16_t* Q = (const GAS bf16_t*)(ws + OFF_Q);
    const GAS bf16_t* Kg = (const GAS bf16_t*)(ws + OFF_KP) + ((size_t)seq_koff(s) * 4 + (size_t)kvh * Lp) * 64;
    const GAS bf16_t* Vg = (const GAS bf16_t*)(ws + OFF_VT) + (size_t)seq_koff(s) * 4 * 64 + (size_t)kvh * 64 * Lp;
    GAS bf16_t* O = (GAS bf16_t*)(ws + OFF_B);
    const int l31 = lane & 31, qi = wave * 32 + l31, hi = lane >> 5;
    const bool qvalid = qb < nblk || qi < 16;
    const int row = qb < nblk ? seq_base(s) + qb * 256 + qi : NTOKR + 16 * s + (qi & 15);
    bf16x8 qf[4];
#pragma unroll
    for (int kk = 0; kk < 4; ++kk) qf[kk] = *(const GAS bf16x8*)(Q + (size_t)row * 1024 + h * 64 + 16 * kk + 8 * hi);
    LAS bf16_t* Ks = (LAS bf16_t*)lds;
    LAS bf16_t* Vs = (LAS bf16_t*)(lds + 2 * 128 * KPITCH * 2);
    const int sr = tid >> 3, sc = (tid & 7) * 8;
    const GAS bf16_t* kgp = Kg + (size_t)sr * 64 + sc;
    const GAS bf16_t* vgp = Vg + (size_t)sr * Lp + sc;
    u32x4 kreg0 = *(const GAS u32x4*)kgp, kreg1 = *(const GAS u32x4*)(kgp + 64 * 64), vreg0 = *(const GAS u32x4*)vgp, vreg1 = *(const GAS u32x4*)(vgp + 64);
    *(LAS u32x4*)(Ks + sr * KPITCH + sc) = kreg0; *(LAS u32x4*)(Ks + (sr + 64) * KPITCH + sc) = kreg1;
    *(LAS u32x4*)(Vs + sr * VPITCH + sc) = vreg0; *(LAS u32x4*)(Vs + sr * VPITCH + sc + 64) = vreg1;
    __syncthreads();
    f32x16 O0, O1, negm;
#pragma unroll
    for (int i = 0; i < 16; ++i) { O0[i] = 0.f; O1[i] = 0.f; negm[i] = 0.f; }
    float lsum = 0.f;
    for (int t = 0; t < ntile; ++t) {
        const int buf = t & 1;
        if (t + 1 < ntile) { const GAS bf16_t* kq = kgp + (size_t)(t + 1) * 128 * 64; const GAS bf16_t* vq = vgp + (t + 1) * 128;
            kreg0 = *(const GAS u32x4*)kq; kreg1 = *(const GAS u32x4*)(kq + 64 * 64); vreg0 = *(const GAS u32x4*)vq; vreg1 = *(const GAS u32x4*)(vq + 64); }
#pragma unroll
        for (int sub = 0; sub < 2; ++sub) {
            if (sub == 1 && t == ntile - 1) break;
            const LAS bf16_t* kt = Ks + buf * 128 * KPITCH + sub * 64 * KPITCH; const LAS bf16_t* vt = Vs + buf * 64 * VPITCH + sub * 64;
            f32x16 S0, S1;
            { const bf16x8 a0 = *(const LAS bf16x8*)(kt + l31 * KPITCH + 8 * hi), a1 = *(const LAS bf16x8*)(kt + (32 + l31) * KPITCH + 8 * hi);
              S0 = __builtin_amdgcn_mfma_f32_32x32x16_bf16(a0, qf[0], negm, 0, 0, 0); S1 = __builtin_amdgcn_mfma_f32_32x32x16_bf16(a1, qf[0], negm, 0, 0, 0); }
#pragma unroll
            for (int kk = 1; kk < 4; ++kk) {
                const bf16x8 a0 = *(const LAS bf16x8*)(kt + l31 * KPITCH + 16 * kk + 8 * hi), a1 = *(const LAS bf16x8*)(kt + (32 + l31) * KPITCH + 16 * kk + 8 * hi);
                S0 = __builtin_amdgcn_mfma_f32_32x32x16_bf16(a0, qf[kk], S0, 0, 0, 0); S1 = __builtin_amdgcn_mfma_f32_32x32x16_bf16(a1, qf[kk], S1, 0, 0, 0);
            }
            if (t == ntile - 1) { const int nv = L - t * 128 - sub * 64; asm volatile("" : "+v"(S0), "+v"(S1));
#pragma unroll
                for (int i = 0; i < 16; ++i) { const int key = (i & 3) + 8 * (i >> 2) + 4 * hi; if (key >= nv) S0[i] = -1e30f; if (key + 32 >= nv) S1[i] = -1e30f; } }
            if (!FAST) {
            float mx = fmaxf(fmaxf(S0[0], S0[1]), S0[2]);
#pragma unroll
            for (int i = 3; i < 15; i += 2) mx = fmaxf(fmaxf(mx, S0[i]), S0[i + 1]);
            mx = fmaxf(fmaxf(mx, S0[15]), S1[0]);
#pragma unroll
            for (int i = 1; i < 15; i += 2) mx = fmaxf(fmaxf(mx, S1[i]), S1[i + 1]);
            mx = fmaxf(mx, S1[15]);
            const bool first = (t == 0 && sub == 0);
            if (__any(first || mx > 8.f)) {
                asm volatile("; rescale");
                mx = fmaxf(mx, __shfl_xor(mx, 32));
                float delta = first ? mx : fmaxf(mx, 0.f), alpha = __builtin_amdgcn_exp2f(-delta);
                asm volatile("" : "+v"(delta), "+v"(alpha));
#pragma unroll
                for (int i = 0; i < 16; ++i) { S0[i] -= delta; S1[i] -= delta; O0[i] *= alpha; O1[i] *= alpha; negm[i] -= delta; }
                lsum *= alpha;
            }
            }
            float ps = 0.f;
#pragma unroll
            for (int i = 0; i < 16; ++i) { S0[i] = __builtin_amdgcn_exp2f(S0[i]); S1[i] = __builtin_amdgcn_exp2f(S1[i]); ps += S0[i] + S1[i]; }
            lsum += ps;
#pragma unroll
            for (int f = 0; f < 2; ++f)
#pragma unroll
                for (int k2 = 0; k2 < 2; ++k2) {
                    u32x4 pw;
                    if (f == 0) { pw.x = cvt_pk_bf16(S0[8 * k2 + 0], S0[8 * k2 + 1]); pw.y = cvt_pk_bf16(S0[8 * k2 + 2], S0[8 * k2 + 3]); pw.z = cvt_pk_bf16(S0[8 * k2 + 4], S0[8 * k2 + 5]); pw.w = cvt_pk_bf16(S0[8 * k2 + 6], S0[8 * k2 + 7]); }
                    else        { pw.x = cvt_pk_bf16(S1[8 * k2 + 0], S1[8 * k2 + 1]); pw.y = cvt_pk_bf16(S1[8 * k2 + 2], S1[8 * k2 + 3]); pw.z = cvt_pk_bf16(S1[8 * k2 + 4], S1[8 * k2 + 5]); pw.w = cvt_pk_bf16(S1[8 * k2 + 6], S1[8 * k2 + 7]); }
                    const bf16x8 pf = __builtin_bit_cast(bf16x8, pw);
                    const int k0 = 32 * f + 16 * k2 + 4 * hi;
                    const LAS bf16_t* v0p = vt + l31 * VPITCH + k0;
                    const LAS bf16_t* v1p = vt + (32 + l31) * VPITCH + k0;
                    const u32x2 a0l = *(const LAS u32x2*)v0p, a0h = *(const LAS u32x2*)(v0p + 8);
                    const u32x2 a1l = *(const LAS u32x2*)v1p, a1h = *(const LAS u32x2*)(v1p + 8);
                    const bf16x8 va0 = __builtin_bit_cast(bf16x8, (u32x4){a0l.x, a0l.y, a0h.x, a0h.y});
                    const bf16x8 va1 = __builtin_bit_cast(bf16x8, (u32x4){a1l.x, a1l.y, a1h.x, a1h.y});
                    O0 = __builtin_amdgcn_mfma_f32_32x32x16_bf16(va0, pf, O0, 0, 0, 0);
                    O1 = __builtin_amdgcn_mfma_f32_32x32x16_bf16(va1, pf, O1, 0, 0, 0);
                }
        }
        if (t + 1 < ntile) { LAS bf16_t* kd = Ks + (buf ^ 1) * 128 * KPITCH; LAS bf16_t* vd = Vs + (buf ^ 1) * 64 * VPITCH;
            *(LAS u32x4*)(kd + sr * KPITCH + sc) = kreg0; *(LAS u32x4*)(kd + (sr + 64) * KPITCH + sc) = kreg1;
            *(LAS u32x4*)(vd + sr * VPITCH + sc) = vreg0; *(LAS u32x4*)(vd + sr * VPITCH + sc + 64) = vreg1; }
        __syncthreads();
    }
    const float inv = 1.f / (lsum + __shfl_xor(lsum, 32));
    if (qvalid) {
        GAS bf16_t* op = O + (size_t)row * DM + h * 64 + 4 * hi;
#pragma unroll
        for (int g4 = 0; g4 < 4; ++g4) {
            u32x2 w0, w1;
            w0.x = cvt_pk_bf16(O0[4 * g4] * inv, O0[4 * g4 + 1] * inv); w0.y = cvt_pk_bf16(O0[4 * g4 + 2] * inv, O0[4 * g4 + 3] * inv);
            w1.x = cvt_pk_bf16(O1[4 * g4] * inv, O1[4 * g4 + 1] * inv); w1.y = cvt_pk_bf16(O1[4 * g4 + 2] * inv, O1[4 * g4 + 3] * inv);
            *(GAS u32x2*)(op + 8 * g4) = w0; *(GAS u32x2*)(op + 32 + 8 * g4) = w1;
        }
    }
}

__device__ __forceinline__ void attn_unit2(unsigned char* ws, LAS unsigned char* lds, int s, int kvh, int qb, int hp, int tid, int wave, int lane, const int FAST) {
    const int L = seq_L(s), Lp = seq_Lpad(s), ntile = Lp >> 7;
    const int h0 = kvh * 4 + hp * 2;
    const GAS bf16_t* Q = (const GAS bf16_t*)(ws + OFF_Q);
    const GAS bf16_t* Kg = (const GAS bf16_t*)(ws + OFF_KP) + ((size_t)seq_koff(s) * 4 + (size_t)kvh * Lp) * 64;
    const GAS bf16_t* Vg = (const GAS bf16_t*)(ws + OFF_VT) + (size_t)seq_koff(s) * 4 * 64 + (size_t)kvh * 64 * Lp;
    GAS bf16_t* O = (GAS bf16_t*)(ws + OFF_B);
    const int l31 = lane & 31, hi = lane >> 5, row = seq_base(s) + qb * 256 + wave * 32 + l31;
    bf16x8 qf[2][4];
#pragma unroll
    for (int nh = 0; nh < 2; ++nh)
#pragma unroll
        for (int kk = 0; kk < 4; ++kk) qf[nh][kk] = __builtin_nontemporal_load((const GAS bf16x8*)(Q + (size_t)row * 1024 + (h0 + nh) * 64 + 16 * kk + 8 * hi));
    LAS bf16_t* Ks = (LAS bf16_t*)lds;
    LAS bf16_t* Vs = (LAS bf16_t*)(lds + 2 * 128 * KPITCH * 2);
    const int sr = tid >> 3, sc = (tid & 7) * 8;
    const GAS bf16_t* kgp = Kg + (size_t)sr * 64 + sc;
    const GAS bf16_t* vgp = Vg + (size_t)sr * Lp + sc;
    u32x4 kreg0 = *(const GAS u32x4*)kgp, kreg1 = *(const GAS u32x4*)(kgp + 64 * 64), vreg0 = *(const GAS u32x4*)vgp, vreg1 = *(const GAS u32x4*)(vgp + 64);
    *(LAS u32x4*)(Ks + sr * KPITCH + sc) = kreg0; *(LAS u32x4*)(Ks + (sr + 64) * KPITCH + sc) = kreg1;
    *(LAS u32x4*)(Vs + sr * VPITCH + sc) = vreg0; *(LAS u32x4*)(Vs + sr * VPITCH + sc + 64) = vreg1;
    __syncthreads();
    f32x16 Oa0, Oa1, Ob0, Ob1, nma, nmb;
#pragma unroll
    for (int i = 0; i < 16; ++i) { Oa0[i] = 0.f; Oa1[i] = 0.f; Ob0[i] = 0.f; Ob1[i] = 0.f; nma[i] = 0.f; nmb[i] = 0.f; }
    float lsa = 0.f, lsb = 0.f;
    for (int t = 0; t < ntile; ++t) {
        const int buf = t & 1;
        if (t + 1 < ntile) { const GAS bf16_t* kq = kgp + (size_t)(t + 1) * 128 * 64; const GAS bf16_t* vq = vgp + (t + 1) * 128;
            kreg0 = *(const GAS u32x4*)kq; kreg1 = *(const GAS u32x4*)(kq + 64 * 64); vreg0 = *(const GAS u32x4*)vq; vreg1 = *(const GAS u32x4*)(vq + 64); }
#pragma unroll
        for (int ks = 0; ks < 4; ++ks) {
            if (ks >= 1 && t == ntile - 1) break;
            const LAS bf16_t* kt = Ks + buf * 128 * KPITCH + ks * 32 * KPITCH + l31 * KPITCH + 8 * hi;
            const LAS bf16_t* vt = Vs + buf * 64 * VPITCH + ks * 32 + l31 * VPITCH + 4 * hi;
            const bf16x8 k0 = *(const LAS bf16x8*)(kt), k1 = *(const LAS bf16x8*)(kt + 16), k2 = *(const LAS bf16x8*)(kt + 32), k3 = *(const LAS bf16x8*)(kt + 48);
            f32x16 Sa = __builtin_amdgcn_mfma_f32_32x32x16_bf16(k0, qf[0][0], nma, 0, 0, 0);
            f32x16 Sb = __builtin_amdgcn_mfma_f32_32x32x16_bf16(k0, qf[1][0], nmb, 0, 0, 0);
            Sa = __builtin_amdgcn_mfma_f32_32x32x16_bf16(k1, qf[0][1], Sa, 0, 0, 0); Sb = __builtin_amdgcn_mfma_f32_32x32x16_bf16(k1, qf[1][1], Sb, 0, 0, 0);
            Sa = __builtin_amdgcn_mfma_f32_32x32x16_bf16(k2, qf[0][2], Sa, 0, 0, 0); Sb = __builtin_amdgcn_mfma_f32_32x32x16_bf16(k2, qf[1][2], Sb, 0, 0, 0);
            Sa = __builtin_amdgcn_mfma_f32_32x32x16_bf16(k3, qf[0][3], Sa, 0, 0, 0); Sb = __builtin_amdgcn_mfma_f32_32x32x16_bf16(k3, qf[1][3], Sb, 0, 0, 0);
            if (t == ntile - 1) { const int nv = L - t * 128 - ks * 32; asm volatile("" : "+v"(Sa), "+v"(Sb));
#pragma unroll
                for (int i = 0; i < 16; ++i) { const int key = (i & 3) + 8 * (i >> 2) + 4 * hi; if (key >= nv) { Sa[i] = -1e30f; Sb[i] = -1e30f; } } }
            if (!FAST) {
            float mxa = fmaxf(fmaxf(Sa[0], Sa[1]), Sa[2]), mxb = fmaxf(fmaxf(Sb[0], Sb[1]), Sb[2]);
#pragma unroll
            for (int i = 3; i < 15; i += 2) { mxa = fmaxf(fmaxf(mxa, Sa[i]), Sa[i + 1]); mxb = fmaxf(fmaxf(mxb, Sb[i]), Sb[i + 1]); }
            mxa = fmaxf(mxa, Sa[15]); mxb = fmaxf(mxb, Sb[15]);
            const bool first = (t == 0 && ks == 0);
            if (__any(first || mxa > 8.f || mxb > 8.f)) {
                asm volatile("; rescale");
                mxa = fmaxf(mxa, __shfl_xor(mxa, 32)); mxb = fmaxf(mxb, __shfl_xor(mxb, 32));
                const float da = first ? mxa : fmaxf(mxa, 0.f), db = first ? mxb : fmaxf(mxb, 0.f);
                float aa = __builtin_amdgcn_exp2f(-da), ab = __builtin_amdgcn_exp2f(-db);
                float da_ = da, db_ = db; asm volatile("" : "+v"(da_), "+v"(db_), "+v"(aa), "+v"(ab));
#pragma unroll
                for (int i = 0; i < 16; ++i) { Sa[i] -= da_; Sb[i] -= db_; Oa0[i] *= aa; Oa1[i] *= aa; Ob0[i] *= ab; Ob1[i] *= ab; nma[i] -= da_; nmb[i] -= db_; }
                lsa *= aa; lsb *= ab;
            }
            }
            float psa = 0.f, psb = 0.f;
#pragma unroll
            for (int i = 0; i < 16; ++i) { Sa[i] = __builtin_amdgcn_exp2f(Sa[i]); Sb[i] = __builtin_amdgcn_exp2f(Sb[i]); psa += Sa[i]; psb += Sb[i]; }
            lsa += psa; lsb += psb;
#pragma unroll
            for (int k2s = 0; k2s < 2; ++k2s) {
                const u32x2 a0l = *(const LAS u32x2*)(vt + 16 * k2s), a0h = *(const LAS u32x2*)(vt + 16 * k2s + 8);
                const u32x2 a1l = *(const LAS u32x2*)(vt + 32 * VPITCH + 16 * k2s), a1h = *(const LAS u32x2*)(vt + 32 * VPITCH + 16 * k2s + 8);
                const bf16x8 va0 = __builtin_bit_cast(bf16x8, (u32x4){a0l.x, a0l.y, a0h.x, a0h.y});
                const bf16x8 va1 = __builtin_bit_cast(bf16x8, (u32x4){a1l.x, a1l.y, a1h.x, a1h.y});
                u32x4 pa, pb;
                pa.x = cvt_pk_bf16(Sa[8 * k2s + 0], Sa[8 * k2s + 1]); pa.y = cvt_pk_bf16(Sa[8 * k2s + 2], Sa[8 * k2s + 3]); pa.z = cvt_pk_bf16(Sa[8 * k2s + 4], Sa[8 * k2s + 5]); pa.w = cvt_pk_bf16(Sa[8 * k2s + 6], Sa[8 * k2s + 7]);
                pb.x = cvt_pk_bf16(Sb[8 * k2s + 0], Sb[8 * k2s + 1]); pb.y = cvt_pk_bf16(Sb[8 * k2s + 2], Sb[8 * k2s + 3]); pb.z = cvt_pk_bf16(Sb[8 * k2s + 4], Sb[8 * k2s + 5]); pb.w = cvt_pk_bf16(Sb[8 * k2s + 6], Sb[8 * k2s + 7]);
                const bf16x8 pfa = __builtin_bit_cast(bf16x8, pa), pfb = __builtin_bit_cast(bf16x8, pb);
                Oa0 = __builtin_amdgcn_mfma_f32_32x32x16_bf16(va0, pfa, Oa0, 0, 0, 0); Ob0 = __builtin_amdgcn_mfma_f32_32x32x16_bf16(va0, pfb, Ob0, 0, 0, 0);
                Oa1 = __builtin_amdgcn_mfma_f32_32x32x16_bf16(va1, pfa, Oa1, 0, 0, 0); Ob1 = __builtin_amdgcn_mfma_f32_32x32x16_bf16(va1, pfb, Ob1, 0, 0, 0);
            }
        }
        if (t + 1 < ntile) { LAS bf16_t* kd = Ks + (buf ^ 1) * 128 * KPITCH; LAS bf16_t* vd = Vs + (buf ^ 1) * 64 * VPITCH;
            *(LAS u32x4*)(kd + sr * KPITCH + sc) = kreg0; *(LAS u32x4*)(kd + (sr + 64) * KPITCH + sc) = kreg1;
            *(LAS u32x4*)(vd + sr * VPITCH + sc) = vreg0; *(LAS u32x4*)(vd + sr * VPITCH + sc + 64) = vreg1; }
        __syncthreads();
    }
    const float inva = 1.f / (lsa + __shfl_xor(lsa, 32)), invb = 1.f / (lsb + __shfl_xor(lsb, 32));
    GAS bf16_t* op = O + (size_t)row * DM + h0 * 64 + 4 * hi;
#pragma unroll
    for (int g4 = 0; g4 < 4; ++g4) {
        u32x2 w0, w1, w2, w3;
        w0.x = cvt_pk_bf16(Oa0[4 * g4] * inva, Oa0[4 * g4 + 1] * inva); w0.y = cvt_pk_bf16(Oa0[4 * g4 + 2] * inva, Oa0[4 * g4 + 3] * inva);
        w1.x = cvt_pk_bf16(Oa1[4 * g4] * inva, Oa1[4 * g4 + 1] * inva); w1.y = cvt_pk_bf16(Oa1[4 * g4 + 2] * inva, Oa1[4 * g4 + 3] * inva);
        w2.x = cvt_pk_bf16(Ob0[4 * g4] * invb, Ob0[4 * g4 + 1] * invb); w2.y = cvt_pk_bf16(Ob0[4 * g4 + 2] * invb, Ob0[4 * g4 + 3] * invb);
        w3.x = cvt_pk_bf16(Ob1[4 * g4] * invb, Ob1[4 * g4 + 1] * invb); w3.y = cvt_pk_bf16(Ob1[4 * g4 + 2] * invb, Ob1[4 * g4 + 3] * invb);
        *(GAS u32x2*)(op + 8 * g4) = w0; *(GAS u32x2*)(op + 32 + 8 * g4) = w1; *(GAS u32x2*)(op + 64 + 8 * g4) = w2; *(GAS u32x2*)(op + 96 + 8 * g4) = w3;
    }
}

__device__ __forceinline__ void attn_unit2f(unsigned char* ws, LAS unsigned char* lds, int s, int kvh, int qb, int hp, int tid, int wave, int lane) {
    const int L = seq_L(s), Lp = seq_Lpad(s), ntile = Lp >> 7;
    const int h0 = kvh * 4 + hp * 2;
    const GAS bf16_t* Q = (const GAS bf16_t*)(ws + OFF_Q);
    const GAS bf16_t* Kg = (const GAS bf16_t*)(ws + OFF_KP) + ((size_t)seq_koff(s) * 4 + (size_t)kvh * Lp) * 64;
    const GAS bf16_t* Vg = (const GAS bf16_t*)(ws + OFF_VT) + (size_t)seq_koff(s) * 4 * 64 + (size_t)kvh * 64 * Lp;
    GAS bf16_t* O = (GAS bf16_t*)(ws + OFF_B);
    const int l31 = lane & 31, hi = lane >> 5, row = seq_base(s) + qb * 256 + wave * 32 + l31;
    bf16x8 qf[2][4];
#pragma unroll
    for (int nh = 0; nh < 2; ++nh)
#pragma unroll
        for (int kk = 0; kk < 4; ++kk) qf[nh][kk] = __builtin_nontemporal_load((const GAS bf16x8*)(Q + (size_t)row * 1024 + (h0 + nh) * 64 + 16 * kk + 8 * hi));
    LAS bf16_t* Ks = (LAS bf16_t*)lds;
    LAS bf16_t* Vs = (LAS bf16_t*)(lds + 2 * 128 * KPITCH * 2);
    const int sr = tid >> 3, sc = (tid & 7) * 8;
    const GAS bf16_t* kgp = Kg + (size_t)sr * 64 + sc;
    const GAS bf16_t* vgp = Vg + (size_t)sr * Lp + sc;
    u32x4 kreg0 = *(const GAS u32x4*)kgp, kreg1 = *(const GAS u32x4*)(kgp + 64 * 64), vreg0 = *(const GAS u32x4*)vgp, vreg1 = *(const GAS u32x4*)(vgp + 64);
    *(LAS u32x4*)(Ks + sr * KPITCH + sc) = kreg0; *(LAS u32x4*)(Ks + (sr + 64) * KPITCH + sc) = kreg1;
    *(LAS u32x4*)(Vs + sr * VPITCH + sc) = vreg0; *(LAS u32x4*)(Vs + sr * VPITCH + sc + 64) = vreg1;
    __syncthreads();
    f32x16 Oa0, Oa1, Ob0, Ob1;
#pragma unroll
    for (int i = 0; i < 16; ++i) { Oa0[i] = 0.f; Oa1[i] = 0.f; Ob0[i] = 0.f; Ob1[i] = 0.f; }
    float lsa = 0.f, lsb = 0.f;
    for (int t = 0; t < ntile; ++t) {
        const int buf = t & 1;
        if (t + 1 < ntile) { const GAS bf16_t* kq = kgp + (size_t)(t + 1) * 128 * 64; const GAS bf16_t* vq = vgp + (t + 1) * 128;
            kreg0 = *(const GAS u32x4*)kq; kreg1 = *(const GAS u32x4*)(kq + 64 * 64); vreg0 = *(const GAS u32x4*)vq; vreg1 = *(const GAS u32x4*)(vq + 64); }
#define ATT2_QK(KS, SA, SB) do { const LAS bf16_t* _kt = Ks + buf * 128 * KPITCH + (KS) * 32 * KPITCH + l31 * KPITCH + 8 * hi; \
            const bf16x8 _k0 = *(const LAS bf16x8*)(_kt), _k1 = *(const LAS bf16x8*)(_kt + 16), _k2 = *(const LAS bf16x8*)(_kt + 32), _k3 = *(const LAS bf16x8*)(_kt + 48); \
            SA = __builtin_amdgcn_mfma_f32_32x32x16_bf16(_k0, qf[0][0], (f32x16)(0.f), 0, 0, 0); SB = __builtin_amdgcn_mfma_f32_32x32x16_bf16(_k0, qf[1][0], (f32x16)(0.f), 0, 0, 0); \
            SA = __builtin_amdgcn_mfma_f32_32x32x16_bf16(_k1, qf[0][1], SA, 0, 0, 0); SB = __builtin_amdgcn_mfma_f32_32x32x16_bf16(_k1, qf[1][1], SB, 0, 0, 0); \
            SA = __builtin_amdgcn_mfma_f32_32x32x16_bf16(_k2, qf[0][2], SA, 0, 0, 0); SB = __builtin_amdgcn_mfma_f32_32x32x16_bf16(_k2, qf[1][2], SB, 0, 0, 0); \
            SA = __builtin_amdgcn_mfma_f32_32x32x16_bf16(_k3, qf[0][3], SA, 0, 0, 0); SB = __builtin_amdgcn_mfma_f32_32x32x16_bf16(_k3, qf[1][3], SB, 0, 0, 0); } while (0)
        const bool lastt = (t == ntile - 1);
        f32x16 Sa, Sb, San, Sbn;
        ATT2_QK(0, Sa, Sb);
#pragma unroll
        for (int ks = 0; ks < 4; ++ks) {
            if (ks >= 1 && lastt) break;
            if (ks + 1 < 4 && !lastt) ATT2_QK(ks + 1, San, Sbn);
            const LAS bf16_t* vt = Vs + buf * 64 * VPITCH + ks * 32 + l31 * VPITCH + 4 * hi;
            if (t == ntile - 1) { const int nv = L - t * 128 - ks * 32; asm volatile("" : "+v"(Sa), "+v"(Sb));
#pragma unroll
                for (int i = 0; i < 16; ++i) { const int key = (i & 3) + 8 * (i >> 2) + 4 * hi; if (key >= nv) { Sa[i] = -1e30f; Sb[i] = -1e30f; } } }
            float psa = 0.f, psb = 0.f;
#pragma unroll
            for (int i = 0; i < 16; ++i) { Sa[i] = __builtin_amdgcn_exp2f(Sa[i]); Sb[i] = __builtin_amdgcn_exp2f(Sb[i]); psa += Sa[i]; psb += Sb[i]; }
            lsa += psa; lsb += psb;
#pragma unroll
            for (int k2s = 0; k2s < 2; ++k2s) {
                const u32x2 a0l = *(const LAS u32x2*)(vt + 16 * k2s), a0h = *(const LAS u32x2*)(vt + 16 * k2s + 8);
                const u32x2 a1l = *(const LAS u32x2*)(vt + 32 * VPITCH + 16 * k2s), a1h = *(const LAS u32x2*)(vt + 32 * VPITCH + 16 * k2s + 8);
                const bf16x8 va0 = __builtin_bit_cast(bf16x8, (u32x4){a0l.x, a0l.y, a0h.x, a0h.y});
                const bf16x8 va1 = __builtin_bit_cast(bf16x8, (u32x4){a1l.x, a1l.y, a1h.x, a1h.y});
                u32x4 pa, pb;
                pa.x = cvt_pk_bf16(Sa[8 * k2s + 0], Sa[8 * k2s + 1]); pa.y = cvt_pk_bf16(Sa[8 * k2s + 2], Sa[8 * k2s + 3]); pa.z = cvt_pk_bf16(Sa[8 * k2s + 4], Sa[8 * k2s + 5]); pa.w = cvt_pk_bf16(Sa[8 * k2s + 6], Sa[8 * k2s + 7]);
                pb.x = cvt_pk_bf16(Sb[8 * k2s + 0], Sb[8 * k2s + 1]); pb.y = cvt_pk_bf16(Sb[8 * k2s + 2], Sb[8 * k2s + 3]); pb.z = cvt_pk_bf16(Sb[8 * k2s + 4], Sb[8 * k2s + 5]); pb.w = cvt_pk_bf16(Sb[8 * k2s + 6], Sb[8 * k2s + 7]);
                const bf16x8 pfa = __builtin_bit_cast(bf16x8, pa), pfb = __builtin_bit_cast(bf16x8, pb);
                Oa0 = __builtin_amdgcn_mfma_f32_32x32x16_bf16(va0, pfa, Oa0, 0, 0, 0); Ob0 = __builtin_amdgcn_mfma_f32_32x32x16_bf16(va0, pfb, Ob0, 0, 0, 0);
                Oa1 = __builtin_amdgcn_mfma_f32_32x32x16_bf16(va1, pfa, Oa1, 0, 0, 0); Ob1 = __builtin_amdgcn_mfma_f32_32x32x16_bf16(va1, pfb, Ob1, 0, 0, 0);
            }
            if (ks + 1 < 4 && !lastt) { Sa = San; Sb = Sbn; }
        }
#undef ATT2_QK
        if (t + 1 < ntile) { LAS bf16_t* kd = Ks + (buf ^ 1) * 128 * KPITCH; LAS bf16_t* vd = Vs + (buf ^ 1) * 64 * VPITCH;
            *(LAS u32x4*)(kd + sr * KPITCH + sc) = kreg0; *(LAS u32x4*)(kd + (sr + 64) * KPITCH + sc) = kreg1;
            *(LAS u32x4*)(vd + sr * VPITCH + sc) = vreg0; *(LAS u32x4*)(vd + sr * VPITCH + sc + 64) = vreg1; }
        __syncthreads();
    }
    const float inva = 1.f / (lsa + __shfl_xor(lsa, 32)), invb = 1.f / (lsb + __shfl_xor(lsb, 32));
    GAS bf16_t* op = O + (size_t)row * DM + h0 * 64 + 4 * hi;
#pragma unroll
    for (int g4 = 0; g4 < 4; ++g4) {
        u32x2 w0, w1, w2, w3;
        w0.x = cvt_pk_bf16(Oa0[4 * g4] * inva, Oa0[4 * g4 + 1] * inva); w0.y = cvt_pk_bf16(Oa0[4 * g4 + 2] * inva, Oa0[4 * g4 + 3] * inva);
        w1.x = cvt_pk_bf16(Oa1[4 * g4] * inva, Oa1[4 * g4 + 1] * inva); w1.y = cvt_pk_bf16(Oa1[4 * g4 + 2] * inva, Oa1[4 * g4 + 3] * inva);
        w2.x = cvt_pk_bf16(Ob0[4 * g4] * invb, Ob0[4 * g4 + 1] * invb); w2.y = cvt_pk_bf16(Ob0[4 * g4 + 2] * invb, Ob0[4 * g4 + 3] * invb);
        w3.x = cvt_pk_bf16(Ob1[4 * g4] * invb, Ob1[4 * g4 + 1] * invb); w3.y = cvt_pk_bf16(Ob1[4 * g4 + 2] * invb, Ob1[4 * g4 + 3] * invb);
        *(GAS u32x2*)(op + 8 * g4) = w0; *(GAS u32x2*)(op + 32 + 8 * g4) = w1; *(GAS u32x2*)(op + 64 + 8 * g4) = w2; *(GAS u32x2*)(op + 96 + 8 * g4) = w3;
    }
}

constexpr int SP = 136;
__device__ __forceinline__ void chunk_decode(int cgl, int& s, int& c, int& p0, int& nvalid) {
    if (cgl < 129) { s = 0; c = cgl; } else { const int q = cgl - 129; s = 1 + q / 17; c = q % 17; }
    if (c == 0) { p0 = 0; nvalid = 16; } else { p0 = 16 + (c - 1) * 128; nvalid = 128; }
}
__device__ __forceinline__ float xbc_at(const bf16_t* XBC, int s, int L, int pos, int ch) { return (pos >= 0 && pos < L) ? bf2f(XBC[(size_t)pos2row(s, pos) * 1536 + ch]) : 0.f; }
__device__ __forceinline__ f32x16 mma32(const LAS bf16_t* A, const LAS bf16_t* B, f32x16 acc, int lane) {
    const LAS bf16_t* ap = A + (lane & 31) * SP + 8 * (lane >> 5); const LAS bf16_t* bp = B + (lane & 31) * SP + 8 * (lane >> 5);
#pragma unroll
    for (int k0 = 0; k0 < 128; k0 += 16) acc = __builtin_amdgcn_mfma_f32_32x32x16_bf16(*(const LAS bf16x8*)(ap + k0), *(const LAS bf16x8*)(bp + k0), acc, 0, 0, 0);
    return acc;
}
#define CONV_LOAD(V, N, ch, t0) do { \
    _Pragma("unroll") for (int _i = 0; _i < (N) + 4; ++_i) { const int _pos = p0 + (t0) + _i - 2; const int _pc = min(max(_pos, 0), L - 1); \
        const float _x = bf2f(XBC[(unsigned)pos2row(s, _pc) * 1536u + (unsigned)(ch)]); V[_i] = (_pos >= 0 && _pos < L) ? _x : 0.f; } } while (0)
#define CONV_EMIT(V, N, ch, t0, EMIT) do { \
    const float _w0 = cw[(ch)], _w1 = cw[1536 + (ch)], _w2 = cw[2 * 1536 + (ch)], _w3 = cw[3 * 1536 + (ch)], _w4 = cw[4 * 1536 + (ch)], _b = cb[(ch)]; \
    _Pragma("unroll") for (int _i = 0; _i < (N); ++_i) { const int _t = (t0) + _i; \
        float _o = _b + _w0 * V[_i] + _w1 * V[_i + 1] + _w2 * V[_i + 2] + _w3 * V[_i + 3] + _w4 * V[_i + 4]; _o = silu_f(_o); if (_t >= nvalid) _o = 0.f; EMIT; } } while (0)

__device__ __forceinline__ void chunk_cumsum(const float* DT, LAS float* VEC, int s, int p0, int nvalid, int h, float Af, float Ab, int wave, int lane, float* decw  ) {
    if (wave == 0) {
        const int t0 = 2 * lane, t1 = t0 + 1;
        const float d0 = t0 < nvalid ? DT[(size_t)pos2row(s, p0 + t0) * 32 + h] : 0.f, d1 = t1 < nvalid ? DT[(size_t)pos2row(s, p0 + t1) * 32 + h] : 0.f;
        const float a0 = d0 * Af, a1 = d1 * Af, ssum = a0 + a1; float inc = ssum;
#pragma unroll
        for (int o = 1; o < 64; o <<= 1) { const float v = shfl_up_l(inc, o, lane); if (lane >= o) inc += v; }
        const float exc = inc - ssum, tot = shfl_idx_l(inc, 63);
        VEC[t0] = exc + a0; VEC[t1] = inc; VEC[256 + t0] = d0; VEC[256 + t1] = d1;
        if (decw) { VEC[512 + t0] = __expf(tot - (exc + a0)) * d0; VEC[512 + t1] = __expf(tot - inc) * d1; if (lane == 0) decw[0] = __expf(tot); }
        else { VEC[512 + t0] = __expf(exc + a0); VEC[512 + t1] = __expf(inc); }
    } else if (wave == 1) {
        const int t0 = 127 - 2 * lane, t1 = t0 - 1;
        const float d0 = t0 < nvalid ? DT[(size_t)pos2row(s, p0 + t0) * 32 + 16 + h] : 0.f, d1 = t1 < nvalid ? DT[(size_t)pos2row(s, p0 + t1) * 32 + 16 + h] : 0.f;
        const float a0 = d0 * Ab, a1 = d1 * Ab, ssum = a0 + a1; float inc = ssum;
#pragma unroll
        for (int o = 1; o < 64; o <<= 1) { const float v = shfl_up_l(inc, o, lane); if (lane >= o) inc += v; }
        const float exc = inc - ssum, tot = shfl_idx_l(inc, 63);
        VEC[128 + t0] = exc + a0; VEC[128 + t1] = inc; VEC[384 + t0] = d0; VEC[384 + t1] = d1;
        if (decw) { VEC[640 + t0] = __expf(tot - (exc + a0)) * d0; VEC[640 + t1] = __expf(tot - inc) * d1; if (lane == 0) decw[1] = __expf(tot); }
        else { VEC[640 + t0] = __expf(exc + a0); VEC[640 + t1] = __expf(inc); }
    }
}

__device__ __forceinline__ void ssd_states_unit(const Params& p, LAS unsigned char* lds, int unit, int tid, int wave, int lane) {
    const int cgl = unit >> 1, g = unit & 1; int s, c, p0, nvalid; chunk_decode(cgl, s, c, p0, nvalid); const int L = seq_L(s);
    const bf16_t* XBC = (const bf16_t*)(p.ws + OFF_XBC); const float* DT = (const float*)(p.ws + OFF_DT);
    const float* cw = p.in[10]; const float* cb = p.in[11];
    bf16_t* ST = (bf16_t*)(p.ws + OFF_STATES); float* DEC = (float*)(p.ws + OFF_DEC);
    LAS bf16_t* Bt = (LAS bf16_t*)lds;
    LAS bf16_t* Xf = Bt + 128 * SP;
    LAS bf16_t* Xb = Xf + 64 * SP;
    LAS float* VEC = (LAS float*)(Xb + 64 * SP);
    { const int n = tid & 127, tq = tid >> 7, ch = 1024 + g * 128 + n; float vb[20];
#pragma unroll 1
      for (int hf = 0; hf < 2; ++hf) { const int t0 = tq * 32 + hf * 16;
          CONV_LOAD(vb, 16, ch, t0);
          CONV_EMIT(vb, 16, ch, t0, Bt[n * SP + _t] = (bf16_t)f2bf(_o)); } }
    for (int hh = 0; hh < 8; ++hh) {
        const int h = g * 8 + hh;
        const float Af = -__expf(p.in[12][h]), Ab = -__expf(p.in[12][16 + h]);
        asm volatile("" : "+s"(p0));
        const int pp = tid & 63, tq = tid >> 6, ch = h * 64 + pp; float vx[20];
        CONV_LOAD(vx, 16, ch, tq * 16);
        chunk_cumsum(DT, VEC, s, p0, nvalid, h, Af, Ab, wave, lane, DEC + ((size_t)cgl * 16 + h) * 2);
        __syncthreads();
        CONV_EMIT(vx, 16, ch, tq * 16, { Xf[pp * SP + _t] = (bf16_t)f2bf(_o * VEC[512 + _t]); Xb[pp * SP + _t] = (bf16_t)f2bf(_o * VEC[640 + _t]); });
        __syncthreads();
        { const int tn = wave & 3, tp = wave >> 2;
          f32x16 af, ab;
#pragma unroll
          for (int i = 0; i < 16; ++i) { af[i] = 0.f; ab[i] = 0.f; }
          af = mma32(Bt + tn * 32 * SP, Xf + tp * 32 * SP, af, lane);
          ab = mma32(Bt + tn * 32 * SP, Xb + tp * 32 * SP, ab, lane);
          const int pcol = tp * 32 + (lane & 31), hi = lane >> 5;
          bf16_t* sf = ST + (((size_t)cgl * 16 + h) * 2) * 8192 + (size_t)pcol * 128 + tn * 32 + 4 * hi;
#pragma unroll
          for (int g4 = 0; g4 < 4; ++g4) {
              u32x2 w0, w1;
              w0.x = cvt_pk_bf16(af[4 * g4], af[4 * g4 + 1]); w0.y = cvt_pk_bf16(af[4 * g4 + 2], af[4 * g4 + 3]);
              w1.x = cvt_pk_bf16(ab[4 * g4], ab[4 * g4 + 1]); w1.y = cvt_pk_bf16(ab[4 * g4 + 2], ab[4 * g4 + 3]);
              *(u32x2*)(sf + 8 * g4) = w0; *(u32x2*)(sf + 8192 + 8 * g4) = w1;
          } }
        __syncthreads();
    }
}

__device__ __forceinline__ void ssd_scan_phase(const Params& p, int wave, int lane) {
    bf16_t* ST = (bf16_t*)(p.ws + OFF_STATES); const float* DEC = (const float*)(p.ws + OFF_DEC);
    for (int k = 0;; ++k) {
        const int wi = (blockIdx.x + gridDim.x * wave) + gridDim.x * 8 * k;
        if (wi >= 4608) break;
        int s, q; if (wi < 512) { s = 0; q = wi; } else { s = 1 + (wi - 512) / 512; q = (wi - 512) % 512; }
        const int hd = q >> 4, h = hd >> 1, dir = hd & 1, e = ((q & 15) * 64 + lane) * 8;
        const int nch = s == 0 ? 129 : 17, cb0 = s == 0 ? 0 : 129 + (s - 1) * 17;
        float carry[8];
#pragma unroll
        for (int i = 0; i < 8; ++i) carry[i] = 0.f;
        const size_t cstride = (size_t)16 * 2 * 8192;
        bf16_t* base = ST + (((size_t)cb0 * 16 + h) * 2 + dir) * 8192 + e;
        const float* dbase = DEC + ((size_t)cb0 * 16 + h) * 2 + dir;
        for (int j0 = 0; j0 < nch; j0 += 8) {
            u32x4 v[8]; float d[8];
#pragma unroll
            for (int jj = 0; jj < 8; ++jj) { const int j = min(j0 + jj, nch - 1), c = dir == 0 ? j : nch - 1 - j;
                v[jj] = __builtin_nontemporal_load((const u32x4*)(base + (size_t)c * cstride)); d[jj] = dbase[(size_t)c * 32]; }
#pragma unroll
            for (int jj = 0; jj < 8; ++jj) { if (j0 + jj < nch) { const int j = j0 + jj, c = dir == 0 ? j : nch - 1 - j;
                u32x4 o; o.x = pk2(carry[0], carry[1]); o.y = pk2(carry[2], carry[3]); o.z = pk2(carry[4], carry[5]); o.w = pk2(carry[6], carry[7]);
                *(u32x4*)(base + (size_t)c * cstride) = o;
                const float dd = d[jj]; const u32x4 vv = v[jj];
                carry[0] = carry[0] * dd + bflo(vv.x); carry[1] = carry[1] * dd + bfhi(vv.x); carry[2] = carry[2] * dd + bflo(vv.y); carry[3] = carry[3] * dd + bfhi(vv.y);
                carry[4] = carry[4] * dd + bflo(vv.z); carry[5] = carry[5] * dd + bfhi(vv.z); carry[6] = carry[6] * dd + bflo(vv.w); carry[7] = carry[7] * dd + bfhi(vv.w); } }
        }
    }
}

__device__ __forceinline__ void ssd_out_unit(const Params& p, LAS unsigned char* lds, int unit, int tid, int wave, int lane) {
    const int cgl = unit >> 1, g = unit & 1; int s, c, p0, nvalid; chunk_decode(cgl, s, c, p0, nvalid); const int L = seq_L(s);
    const bf16_t* XBC = (const bf16_t*)(p.ws + OFF_XBC); const float* DT = (const float*)(p.ws + OFF_DT); const bf16_t* Z = (const bf16_t*)(p.ws + OFF_Z);
    const float* cw = p.in[10]; const float* cb = p.in[11];
    const bf16_t* ST = (const bf16_t*)(p.ws + OFF_STATES);
    bf16_t* MIX = (bf16_t*)(p.ws + OFF_B);
    LAS bf16_t* Cs = (LAS bf16_t*)lds;
    LAS bf16_t* BG = Cs + 128 * SP;
    LAS bf16_t* Xt = BG + 128 * SP;
    LAS bf16_t* Pf = Xt + 64 * SP;
    LAS bf16_t* Pb = Pf + 64 * SP;
    LAS float* VEC = (LAS float*)(Pb + 64 * SP);
    LAS float* RSS = VEC + 768;
    const int hi = lane >> 5, l31 = lane & 31;
    int rowbase = c == 0 ? NTOKR + 16 * s : seq_base(s) + (c - 1) * 128;
    { const int n = tid & 127, tq = tid >> 7, chB = 1024 + g * 128 + n, chC = 1280 + g * 128 + n; float vb[20], vc[20];
#pragma unroll 1
      for (int hf = 0; hf < 2; ++hf) { const int t0 = tq * 32 + hf * 16;
          CONV_LOAD(vb, 16, chB, t0); CONV_LOAD(vc, 16, chC, t0);
          CONV_EMIT(vb, 16, chB, t0, BG[_t * SP + n] = (bf16_t)f2bf(_o));
          CONV_EMIT(vc, 16, chC, t0, Cs[_t * SP + n] = (bf16_t)f2bf(_o)); } }
    if (tid < 128) RSS[tid] = 0.f;
    __syncthreads();
    const int ts = wave & 3, ttb = 2 * (wave >> 2);
    f32x16 cbt0, cbt1;
#pragma unroll
    for (int i = 0; i < 16; ++i) { cbt0[i] = 0.f; cbt1[i] = 0.f; }
    cbt0 = mma32(BG + ts * 32 * SP, Cs + ttb * 32 * SP, cbt0, lane);
    cbt1 = mma32(BG + ts * 32 * SP, Cs + (ttb + 1) * 32 * SP, cbt1, lane);
    __syncthreads();
    float qacc[16];
#pragma unroll
    for (int i = 0; i < 16; ++i) qacc[i] = 0.f;
    for (int hh = 0; hh < 8; ++hh) {
        const int h = g * 8 + hh;
        const float Af = -__expf(p.in[12][h]), Ab = -__expf(p.in[12][16 + h]), Dh = p.in[14][h];
        asm volatile("" : "+s"(p0)); asm volatile("" : "+s"(rowbase));
        int lane_h = lane; asm volatile("" : "+v"(lane_h)); const int hi = lane_h >> 5, l31 = lane_h & 31;
        int tid_h = tid; asm volatile("" : "+v"(tid_h));
        const int cpp = tid_h & 63, ctq = tid_h >> 6, cch = h * 64 + cpp; float vx[20];
        CONV_LOAD(vx, 16, cch, ctq * 16);
        const bf16_t* sf = ST + (((size_t)cgl * 16 + h) * 2) * 8192;
        const u32x4 pf0 = __builtin_nontemporal_load((const u32x4*)(sf + tid_h * 8)), pf1 = __builtin_nontemporal_load((const u32x4*)(sf + (tid_h + 512) * 8)), pb0 = __builtin_nontemporal_load((const u32x4*)(sf + 8192 + tid_h * 8)), pb1 = __builtin_nontemporal_load((const u32x4*)(sf + 8192 + (tid_h + 512) * 8));
        bf16_t zr[16];
        { const int tt = wave & 3, tp = wave >> 2; const unsigned zb = (unsigned)rowbase * 1024u + (unsigned)(h * 64 + tp * 32 + l31);
#pragma unroll
          for (int i = 0; i < 16; ++i) { const int t = min(tt * 32 + (i & 3) + 8 * (i >> 2) + 4 * hi, nvalid - 1); zr[i] = __builtin_nontemporal_load(&Z[zb + (unsigned)t * 1024u]); } }
        chunk_cumsum(DT, VEC, s, p0, nvalid, h, Af, Ab, wave, lane_h, nullptr);
        CONV_EMIT(vx, 16, cch, ctq * 16, Xt[cpp * SP + _t] = (bf16_t)f2bf(_o));
        { const int e0 = tid_h * 8, e1 = (tid_h + 512) * 8;
          *(LAS u32x4*)(Pf + (e0 >> 7) * SP + (e0 & 127)) = pf0; *(LAS u32x4*)(Pf + (e1 >> 7) * SP + (e1 & 127)) = pf1;
          *(LAS u32x4*)(Pb + (e0 >> 7) * SP + (e0 & 127)) = pb0; *(LAS u32x4*)(Pb + (e1 >> 7) * SP + (e1 & 127)) = pb1; }
        __syncthreads();
#pragma unroll
        for (int j = 0; j < 2; ++j) {
            const int tt = ttb + j, tc = tt * 32 + l31; const float at = VEC[tc], rt = VEC[128 + tc];
            LAS bf16_t* gp = BG + tc * SP + ts * 32 + 4 * hi;
            if (ts < tt) {
#pragma unroll
                for (int g4 = 0; g4 < 4; ++g4) { float gv[4];
#pragma unroll
                    for (int i = 0; i < 4; ++i) { const int sr = ts * 32 + 8 * g4 + 4 * hi + i; const float cb = j == 0 ? cbt0[4 * g4 + i] : cbt1[4 * g4 + i];
                        gv[i] = cb * (__expf(at - VEC[sr]) * VEC[256 + sr]); }
                    u32x2 w; w.x = cvt_pk_bf16(gv[0], gv[1]); w.y = cvt_pk_bf16(gv[2], gv[3]); *(LAS u32x2*)(gp + 8 * g4) = w; }
            } else if (ts > tt) {
#pragma unroll
                for (int g4 = 0; g4 < 4; ++g4) { float gv[4];
#pragma unroll
                    for (int i = 0; i < 4; ++i) { const int sr = ts * 32 + 8 * g4 + 4 * hi + i; const float cb = j == 0 ? cbt0[4 * g4 + i] : cbt1[4 * g4 + i];
                        gv[i] = cb * (__expf(rt - VEC[128 + sr]) * VEC[384 + sr]); }
                    u32x2 w; w.x = cvt_pk_bf16(gv[0], gv[1]); w.y = cvt_pk_bf16(gv[2], gv[3]); *(LAS u32x2*)(gp + 8 * g4) = w; }
            } else {
#pragma unroll
                for (int g4 = 0; g4 < 4; ++g4) { float gv[4];
#pragma unroll
                    for (int i = 0; i < 4; ++i) { const int sr = ts * 32 + 8 * g4 + 4 * hi + i; const float cb = j == 0 ? cbt0[4 * g4 + i] : cbt1[4 * g4 + i];
                        const float lf = sr <= tc ? __expf(at - VEC[sr]) * VEC[256 + sr] : 0.f, lb = sr >= tc ? __expf(rt - VEC[128 + sr]) * VEC[384 + sr] : 0.f;
                        gv[i] = cb * (lf + lb); }
                    u32x2 w; w.x = cvt_pk_bf16(gv[0], gv[1]); w.y = cvt_pk_bf16(gv[2], gv[3]); *(LAS u32x2*)(gp + 8 * g4) = w; }
            }
        }
        __syncthreads();
        { const int tt = wave & 3, tp = wave >> 2;
          f32x16 yd, yf, yb;
#pragma unroll
          for (int i = 0; i < 16; ++i) { yd[i] = 0.f; yf[i] = 0.f; yb[i] = 0.f; }
          yd = mma32(BG + tt * 32 * SP, Xt + tp * 32 * SP, yd, lane);
          yf = mma32(Cs + tt * 32 * SP, Pf + tp * 32 * SP, yf, lane);
          yb = mma32(Cs + tt * 32 * SP, Pb + tp * 32 * SP, yb, lane);
          const int pcol = tp * 32 + l31;
          const unsigned mbase = (unsigned)rowbase * 2048u + 1024u + (unsigned)(h * 64 + pcol);
#pragma unroll
          for (int i = 0; i < 16; ++i) {
              const int t = tt * 32 + (i & 3) + 8 * (i >> 2) + 4 * hi;
              if (t < nvalid) {
                  float y = yd[i] + VEC[512 + t] * yf[i] + VEC[640 + t] * yb[i] + Dh * bf2f(Xt[pcol * SP + t]);
                  const float z = bf2f(zr[i]);
                  y *= silu_f(z);
                  MIX[(size_t)(mbase + (unsigned)t * 2048u)] = (bf16_t)f2bf(y);
                  qacc[i] += y * y;
              }
              if ((i & 3) == 3) __builtin_amdgcn_sched_barrier(0);
          } }
        __syncthreads();
    }
    { const int tt = wave & 3, hi2 = lane >> 5;
#pragma unroll
      for (int i = 0; i < 16; ++i) { float q = qacc[i];
          q += __shfl_xor(q, 1); q += __shfl_xor(q, 2); q += __shfl_xor(q, 4); q += __shfl_xor(q, 8); q += __shfl_xor(q, 16);
          const int t = tt * 32 + (i & 3) + 8 * (i >> 2) + 4 * hi2;
          if ((lane & 31) == 0) atomicAdd((float*)(RSS + t), q); } }
    __syncthreads();
    __threadfence();
    __syncthreads();
    {
      const float* ng = p.in[17] + g * 512;
#pragma unroll 4
      for (int k = 0; k < 16; ++k) { const int idx = tid + 512 * k, row = idx >> 6, c = (idx & 63) * 8;
          if (row < nvalid) { const float rs = rsqrtf(RSS[row] * (1.f / 512.f) + EPS);
              u32x4* mp = (u32x4*)(MIX + (size_t)(rowbase + row) * DM + 1024 + g * 512 + c); const u32x4 v = *mp;
              const f32x4 g0 = *(const f32x4*)(ng + c), g1 = *(const f32x4*)(ng + c + 4);
              u32x4 o; o.x = pk2(bflo(v.x) * rs * g0.x, bfhi(v.x) * rs * g0.y); o.y = pk2(bflo(v.y) * rs * g0.z, bfhi(v.y) * rs * g0.w);
              o.z = pk2(bflo(v.z) * rs * g1.x, bfhi(v.z) * rs * g1.y); o.w = pk2(bflo(v.w) * rs * g1.z, bfhi(v.w) * rs * g1.w);
              *mp = o; } } }
    __syncthreads();
}

#define XB_TMO      128
#define XB_XCNT(j)  (256  + 64 * (j))
#define XB_XSUB(j)  (1280 + 64 * (j))
#define XB_XGEN(j)  (2304 + 64 * (j))
#define XB_TOP      3328
#define XB_TOPGEN   3392
#define XCD_BAR_WORDS 3456
#define XB_SPIN_CAP (1u << 22)
__device__ __forceinline__ unsigned xb_ld(unsigned* p)              { return __hip_atomic_load(p, __ATOMIC_RELAXED, __HIP_MEMORY_SCOPE_AGENT); }
__device__ __forceinline__ unsigned xb_add(unsigned* p, unsigned v) { return __hip_atomic_fetch_add(p, v, __ATOMIC_RELAXED, __HIP_MEMORY_SCOPE_AGENT); }
__device__ __forceinline__ unsigned xb_xcc_id() { return (unsigned)__builtin_amdgcn_s_getreg((3 << 11) | 20) & 0xFu; }
#define XB_SPIN(cond, bar) do { unsigned _sp = 0; while (cond) { __builtin_amdgcn_s_sleep(1); \
    if ((++_sp & 255u) == 0u) { if (xb_ld(&(bar)[XB_TMO])) break; if (_sp > XB_SPIN_CAP) { atomicAdd(&(bar)[XB_TMO], 1u); break; } } } } while (0)
struct XcdBarrier { unsigned* bar; unsigned x; volatile LAS unsigned* st; };
__device__ __forceinline__ XcdBarrier xcd_barrier_post(unsigned* bar, volatile LAS unsigned* st) {
    XcdBarrier b; b.bar = bar; b.x = xb_xcc_id(); b.st = st;
    if (threadIdx.x == 0) (void)xb_add(&bar[XB_XCNT(b.x)], 1u);
    return b;
}
__device__ __forceinline__ void xcd_barrier_complete(unsigned* bar, unsigned x, unsigned& nloc, unsigned& nx) {
    const unsigned G = gridDim.x * gridDim.y * gridDim.z;
    unsigned sum, cnt, mine, sp = 0u;
    for (;;) {
        sum = 0u; cnt = 0u; mine = 0u;
#pragma unroll
        for (unsigned j = 0; j < 16; ++j) { const unsigned c = xb_ld(&bar[XB_XCNT(j)]); sum += c; cnt += (c > 0u) ? 1u : 0u; mine = (j == x) ? c : mine; }
        if (sum == G) break;
        __builtin_amdgcn_s_sleep(1);
        if ((++sp & 255u) == 0u) { if (xb_ld(&bar[XB_TMO])) break; if (sp > XB_SPIN_CAP) { atomicAdd(&bar[XB_TMO], 1u); break; } }
    }
    nloc = mine > 0u ? mine : 1u; nx = cnt > 0u ? cnt : 1u;
}
__device__ __forceinline__ void xcd_barrier(const XcdBarrier& b, const int tid) {
    asm volatile("s_waitcnt vmcnt(0)" ::: "memory");
    __syncthreads();
    if (tid == 0) {
        unsigned* bar = b.bar;
        __builtin_amdgcn_s_waitcnt(0);
        unsigned nloc = b.st[0], nx = b.st[1];
        if (nloc == 0u) { xcd_barrier_complete(bar, b.x, nloc, nx); b.st[0] = nloc; b.st[1] = nx; }
        const unsigned old = xb_add(&bar[XB_XSUB(b.x)], 1u);
        const unsigned gen = old / nloc;
        if (old + 1u == (gen + 1u) * nloc) {
            __builtin_amdgcn_fence(__ATOMIC_RELEASE, "agent");
            asm volatile("s_waitcnt vmcnt(0)" ::: "memory");
            const unsigned og = xb_add(&bar[XB_TOP], 1u);
            const unsigned tg = og / nx;
            if (og + 1u == (tg + 1u) * nx) xb_add(&bar[XB_TOPGEN], 1u);
            else XB_SPIN(xb_ld(&bar[XB_TOPGEN]) == tg, bar);
            __builtin_amdgcn_fence(__ATOMIC_ACQUIRE, "agent");
            xb_add(&bar[XB_XGEN(b.x)], 1u);
            asm volatile("s_waitcnt vmcnt(0)" ::: "memory");
        } else {
            XB_SPIN(xb_ld(&bar[XB_XGEN(b.x)]) == gen, bar);
            __builtin_amdgcn_fence(__ATOMIC_ACQUIRE, "agent");
            asm volatile("s_waitcnt vmcnt(0)" ::: "memory");
        }
    }
    __syncthreads();
}

__global__ void __launch_bounds__(512, 2) fwd_kernel(Params p) {
    extern __shared__ __attribute__((aligned(16))) unsigned char lds_raw[];
    cg::grid_group grid = cg::this_grid();
    LAS unsigned char* lds = (LAS unsigned char*)lds_raw;
    const int G = gridDim.x;
    const int wave_s = __builtin_amdgcn_readfirstlane((int)threadIdx.x >> 6);
    int ph = 0;
    { volatile LAS unsigned* st0 = (volatile LAS unsigned*)(lds + MISC_LDS) + 8; if (threadIdx.x < 2) st0[threadIdx.x] = 0u; }
    __syncthreads();
    const XcdBarrier xbar = xcd_barrier_post((unsigned*)(p.ws + OFF_BAR), (volatile LAS unsigned*)(lds + MISC_LDS) + 8);
    if (p.ph_hi < 0) grid.sync();
#define PH_BEGIN if (p.ph_lo <= ph && ph < p.ph_hi) { int wv_ = wave_s; asm volatile("" : "+s"(wv_)); int tid = (wv_ << 6) + (int)__builtin_amdgcn_mbcnt_hi(~0u, __builtin_amdgcn_mbcnt_lo(~0u, 0u)); asm volatile("" : "+v"(tid)); const int lane = tid & 63, wave = __builtin_amdgcn_readfirstlane(tid >> 6); \
        const int gw = blockIdx.x * 8 + wave, NGW = G * 8; unsigned char* ws = p.ws; asm volatile("" : "+s"(ws)); ws = (unsigned char*)(GAS unsigned char*)ws; unsigned* CTL = (unsigned*)(ws + OFF_CTL); bf16_t* Breg = (bf16_t*)(ws + OFF_B); \
        (void)lane; (void)gw; (void)NGW; (void)CTL; (void)Breg;
#define PH_END if (ph + 1 < p.ph_hi) xcd_barrier(xbar, tid); } ++ph;

    PH_BEGIN
        if (blockIdx.x == 0 && tid < 16) CTL[tid] = 0u;
        LAS float* scr = (LAS float*)(lds + wave * 16384);
        convert_ffn(p.in[4], p.in[5], p.in[6], (bf16_t*)(ws + OFF_GU1), (bf16_t*)(ws + OFF_DN1), scr, gw, NGW, lane);
        for (int it = gw; it < 32 * 129; it += NGW) { const int kb = it / 129, nb = it % 129; transpose_item(p.in[9], DM, 4128, (bf16_t*)(ws + OFF_WIN), nb * 32, kb * 64, nb * 32, scr, lane); }
        for (int it = gw; it < 32 * 64; it += NGW) { const int kb = it / 64, nb = it % 64; transpose_item(p.in[18], DM, DM, (bf16_t*)(ws + OFF_WOUT), nb * 32, kb * 64, nb * 32, scr, lane); }
        { u32x4* zp = (u32x4*)(ws + OFF_WIN + (size_t)4128 * DM * 2); const int nz = (NINP - 4128) * DM * 2 / 16;
          for (int i = blockIdx.x * 512 + tid; i < nz; i += G * 512) zp[i] = (u32x4){0u, 0u, 0u, 0u}; }
        row_pass<0>(p, wave, lane, nullptr, p.in[3], nullptr, Breg, 0.f, 0);
    PH_END

    { constexpr int step = 0;
        for (int half = 0; half < 2; ++half) {
            const int row0 = half * 16384, Mh = half == 0 ? 16384 : 16640;
            PH_BEGIN
                pg8::Gemm g{Breg + (size_t)row0 * DM, (const bf16_t*)(ws + (step == 0 ? OFF_GU1 : OFF_GU2)), Mh, 2 * FF, DM}; pg8::StaticOrder S; S.init(Mh, 2 * FF, G, (int)blockIdx.x);
                pg8::EpiSwiglu E{(bf16_t*)(ws + OFF_HID)};
                pg8::gemm_phase<pg8::EpiSwiglu>(lds, g, S, E, tid);
                if (half == 1) { if (step == 0) row_pass_chunks<1>(p, (LAS int*)(lds + MISC_LDS), CTL + 6, 3, tid, wave, lane, p.in[7], p.in[8], Breg, Breg, 0.5f);
                                 else row_pass_chunks<3>(p, (LAS int*)(lds + MISC_LDS), CTL + 7, 2, tid, wave, lane, p.in[24], nullptr, Breg, nullptr, 0.5f); }
            PH_END
            PH_BEGIN
                pg8::Gemm g{(const bf16_t*)(ws + OFF_HID), (const bf16_t*)(ws + (step == 0 ? OFF_DN1 : OFF_DN2)), 16384, DM, FF}; pg8::StaticOrder S; S.init(16384, DM, G, (int)blockIdx.x);
                pg8::EpiStore E{Breg + (size_t)row0 * DM, DM};
                pg8::gemm_phase<pg8::EpiStore>(lds, g, S, E, tid);
                if (half == 1) { if (step == 0) row_pass_chunks<1>(p, (LAS int*)(lds + MISC_LDS), CTL + 6, 1 << 30, tid, wave, lane, p.in[7], p.in[8], Breg, Breg, 0.5f);
                                 else row_pass_chunks<3>(p, (LAS int*)(lds + MISC_LDS), CTL + 7, 1 << 30, tid, wave, lane, p.in[24], nullptr, Breg, nullptr, 0.5f); }
            PH_END
        }
    }
    {
            PH_BEGIN
                { pg8::Gemm g{(const bf16_t*)(ws + OFF_HID) + (size_t)16384 * FF, (const bf16_t*)(ws + OFF_DN1), 256, DM, FF}; pg8::StaticOrder S; S.init(256, DM, G, (int)blockIdx.x);
                  pg8::EpiStore E{Breg + (size_t)NTOKR * DM, DM};
                  pg8::gemm_phase<pg8::EpiStore>(lds, g, S, E, tid); }
                row_pass_chunks<1>(p, (LAS int*)(lds + MISC_LDS), CTL + 6, 1 << 30, tid, wave, lane, p.in[7], p.in[8], Breg, Breg, 0.5f);
                row_pass_chunks<1>(p, (LAS int*)(lds + MISC_LDS), CTL + 9, 1 << 30, tid, wave, lane, p.in[7], p.in[8], Breg, Breg, 0.5f, RP_CHUNKS);
            PH_END
            PH_BEGIN
                row_pass<1>(p, wave, lane, p.in[7], p.in[8], Breg, Breg, 0.5f, NTOKR);
            PH_END
            PH_BEGIN
                pg8::Gemm g{Breg, (const bf16_t*)(ws + OFF_WIN), ROWSP, NINP, DM}; pg8::StaticOrder S; S.init(ROWSP, NINP, G, (int)blockIdx.x);
                pg8::EpiInproj E{(bf16_t*)(ws + OFF_Q), (bf16_t*)(ws + OFF_KP), (bf16_t*)(ws + OFF_VT), (bf16_t*)(ws + OFF_Z), (bf16_t*)(ws + OFF_XBC), (float*)(ws + OFF_DT), p.in[13]};
                pg8::gemm_phase<pg8::EpiInproj>(lds, g, S, E, tid);
            PH_END
            PH_BEGIN
                LAS int* MISC = (LAS int*)(lds + MISC_LDS);
                prep_pads(p, tid);
                for (;;) {
                    if (tid == 0) MISC[0] = (int)atomicAdd(CTL + 1, 1u);
                    __syncthreads();
                    const int u = __builtin_amdgcn_readfirstlane(MISC[0]);
                    __syncthreads();
                    if (u >= NCHUNK * 2 + PREP_NCHUNK) break;
                    if (u < NCHUNK * 2) ssd_states_unit(p, lds, u, tid, wave, lane); else prep_rows(p, u - NCHUNK * 2, wave, lane);
                }
            PH_END
            PH_BEGIN
                ssd_scan_phase(p, wave, lane);
            PH_END
            PH_BEGIN
                LAS int* MISC = (LAS int*)(lds + MISC_LDS);
                constexpr int Q1 = ATT_BIG, Q3 = Q1 + 512, Q4 = Q3 + 512;
                bool fast0;
                { float mq = fabsf(p.in[15][lane]), mk = fabsf(p.in[16][lane]);
#pragma unroll
                  for (int o = 1; o < 64; o <<= 1) { mq = fmaxf(mq, __shfl_xor(mq, o)); mk = fmaxf(mk, __shfl_xor(mk, o)); }
                  const float bound = 8.f * 1.4426950408889634f * mq * mk;
                  fast0 = __builtin_amdgcn_readfirstlane((int)(bound < 60.f)) != 0; }
                int fast_i = fast0 ? 1 : 0;
                for (;;) {
                    unsigned char* wsl = ws; asm volatile("" : "+s"(wsl)); wsl = (unsigned char*)(GAS unsigned char*)wsl;
                    int tidl = tid; asm volatile("" : "+v"(tidl)); const int lanel = tidl & 63;
                    if (tidl == 0) MISC[0] = (int)atomicAdd((unsigned*)(wsl + OFF_CTL) + 3, 1u);
                    __syncthreads();
                    const int u = __builtin_amdgcn_readfirstlane(MISC[0]);
                    __syncthreads();
                    if (u >= Q4) break;
                    asm volatile("" : "+s"(fast_i));
                    if (u < Q1) { if (fast_i) attn_unit2f(wsl, lds, 0, u >> 7, (u & 127) >> 1, u & 1, tidl, wave, lanel); else attn_unit2(wsl, lds, 0, u >> 7, (u & 127) >> 1, u & 1, tidl, wave, lanel, 0); }
                    else if (u < Q3) { const int j = u - Q1, jj = j >> 1; const int cgl = jj < 128 ? 1 + jj : 129 + 17 * ((jj - 128) >> 4) + 1 + ((jj - 128) & 15);
                        ssd_out_unit(p, lds, cgl * 2 + (j & 1), tidl, wave, lanel); }
                    else { const int v = u - Q3; if (fast_i) attn_unit2f(wsl, lds, 1 + (v >> 6), (v >> 4) & 3, (v >> 1) & 7, v & 1, tidl, wave, lanel); else attn_unit2(wsl, lds, 1 + (v >> 6), (v >> 4) & 3, (v >> 1) & 7, v & 1, tidl, wave, lanel, 0); }
                }
            PH_END
            PH_BEGIN
                pg8::Gemm g{Breg, (const bf16_t*)(ws + OFF_WOUT), NTOKR, DM, DM}; pg8::StaticOrder S; S.init(NTOKR, DM, G, (int)blockIdx.x);
                pg8::EpiStore E{(bf16_t*)(ws + OFF_MO), DM};
                pg8::gemm_phase<pg8::EpiStore>(lds, g, S, E, tid);
                convert_ffn_dyn(p.in[21], p.in[22], p.in[23], (bf16_t*)(ws + OFF_GU2), (bf16_t*)(ws + OFF_DN2), lds, CTL + 8, 3, tid, wave, lane);
            PH_END
            PH_BEGIN
                convert_ffn_dyn(p.in[21], p.in[22], p.in[23], (bf16_t*)(ws + OFF_GU2), (bf16_t*)(ws + OFF_DN2), lds, CTL + 8, 1 << 30, tid, wave, lane);
                row_pass<2>(p, wave, lane, p.in[19], p.in[20], (const bf16_t*)(ws + OFF_MO), Breg, 1.0f, 0);
            PH_END
    }
    { constexpr int step = 1;
        for (int half = 0; half < 2; ++half) {
            const int row0 = half * 16384, Mh = 16384;
            PH_BEGIN
                pg8::Gemm g{Breg + (size_t)row0 * DM, (const bf16_t*)(ws + (step == 0 ? OFF_GU1 : OFF_GU2)), Mh, 2 * FF, DM}; pg8::StaticOrder S; S.init(Mh, 2 * FF, G, (int)blockIdx.x);
                pg8::EpiSwiglu E{(bf16_t*)(ws + OFF_HID)};
                pg8::gemm_phase<pg8::EpiSwiglu>(lds, g, S, E, tid);
                if (half == 1) { if (step == 0) row_pass_chunks<1>(p, (LAS int*)(lds + MISC_LDS), CTL + 6, 3, tid, wave, lane, p.in[7], p.in[8], Breg, Breg, 0.5f);
                                 else row_pass_chunks<3>(p, (LAS int*)(lds + MISC_LDS), CTL + 7, 2, tid, wave, lane, p.in[24], nullptr, Breg, nullptr, 0.5f); }
            PH_END
            PH_BEGIN
                pg8::Gemm g{(const bf16_t*)(ws + OFF_HID), (const bf16_t*)(ws + (step == 0 ? OFF_DN1 : OFF_DN2)), Mh, DM, FF}; pg8::StaticOrder S; S.init(Mh, DM, G, (int)blockIdx.x);
                pg8::EpiStore E{Breg + (size_t)row0 * DM, DM};
                pg8::gemm_phase<pg8::EpiStore>(lds, g, S, E, tid);
                if (half == 1) { if (step == 0) row_pass_chunks<1>(p, (LAS int*)(lds + MISC_LDS), CTL + 6, 1 << 30, tid, wave, lane, p.in[7], p.in[8], Breg, Breg, 0.5f);
                                 else row_pass_chunks<3>(p, (LAS int*)(lds + MISC_LDS), CTL + 7, 1 << 30, tid, wave, lane, p.in[24], nullptr, Breg, nullptr, 0.5f); }
            PH_END
        }
    }
    {
            PH_BEGIN
                row_pass_chunks<3>(p, (LAS int*)(lds + MISC_LDS), CTL + 7, 1 << 30, tid, wave, lane, p.in[24], nullptr, Breg, nullptr, 0.5f);
                row_pass<3>(p, wave, lane, p.in[24], nullptr, Breg, nullptr, 0.5f, 16384);
            PH_END
    }
#undef PH_BEGIN
#undef PH_END
}

extern "C" void kernel_launch(void* const* d_in, const int* in_sizes, int n_in, void* d_out, int out_size, void* d_ws, size_t ws_size, hipStream_t stream) {
    static int grid_blocks = 0;
    if (grid_blocks == 0) {
        if (n_in != 25 || ws_size < OFF_END) { fprintf(stderr, "kernel_launch: unexpected n_in %d / ws_size %zu (need %zu)\n", n_in, ws_size, (size_t)OFF_END); grid_blocks = -1; return; }
        int dev = 0, cus = 0, per_cu = 0;
        hipGetDevice(&dev);
        hipDeviceGetAttribute(&cus, hipDeviceAttributeMultiprocessorCount, dev);
        if (hipFuncSetAttribute((const void*)fwd_kernel, hipFuncAttributeMaxDynamicSharedMemorySize, LDS_BYTES) != hipSuccess) fprintf(stderr, "kernel_launch: hipFuncSetAttribute failed\n");
        if (hipOccupancyMaxActiveBlocksPerMultiprocessor(&per_cu, (const void*)fwd_kernel, 512, LDS_BYTES) != hipSuccess || per_cu < 1) per_cu = 1;
        (void)hipGetLastError();
        if (per_cu > 1) per_cu = 1;
        grid_blocks = cus * per_cu;
    }
    if (grid_blocks < 0) return;
    Params p{};
    for (int i = 0; i < 25; ++i) p.in[i] = (const float*)d_in[i];
    p.out = (float*)d_out; p.ws = (unsigned char*)d_ws; p.ph_lo = 0; p.ph_hi = 1000;
    if (hipMemsetAsync((unsigned char*)d_ws + OFF_BAR, 0, (size_t)XCD_BAR_WORDS * 4, stream) != hipSuccess) { fprintf(stderr, "kernel_launch: memset of the barrier words failed\n"); return; }
    void* args[] = {&p};
    hipError_t e = hipLaunchCooperativeKernel((const void*)fwd_kernel, dim3(grid_blocks), dim3(512), args, LDS_BYTES, stream);
    if (e != hipSuccess) fprintf(stderr, "cooperative launch failed: %s (grid %d)\n", hipGetErrorString(e), grid_blocks);
}
```

```cpp
#include <hip/hip_runtime.h>
#include <hip/hip_cooperative_groups.h>
#include <cstdio>
#include <cstdint>
namespace cg = cooperative_groups;

#define LAS __attribute__((address_space(3)))
#define GAS __attribute__((address_space(1)))
typedef unsigned short bf16_t;
typedef short bf16x8 __attribute__((ext_vector_type(8)));
typedef short s16x4 __attribute__((ext_vector_type(4)));
typedef float f32x4 __attribute__((ext_vector_type(4)));
typedef float f32x16 __attribute__((ext_vector_type(16)));
typedef unsigned u32x4 __attribute__((ext_vector_type(4)));
typedef unsigned u32x2 __attribute__((ext_vector_type(2)));

constexpr int DM = 2048, FF = 5632, NTOKR = 32768, NSEQ = 9, ROWS = NTOKR + NSEQ * 16  , ROWSP = 33024  ;
constexpr int NINP = 4352;
constexpr int NCHUNK = 265;
constexpr float EPS = 1e-6f;
constexpr float QSCALE = 0.125f * 1.4426950408889634f;
constexpr int KVPOS = 16512 + 8 * 2176;

constexpr size_t SZ_WIN = (size_t)NINP * DM * 2, SZ_WOUT = (size_t)DM * DM * 2, SZ_GU = (size_t)2 * FF * DM * 2, SZ_DN = (size_t)DM * FF * 2;
constexpr size_t OFF_WIN = 0, OFF_WOUT = OFF_WIN + SZ_WIN, OFF_GU1 = OFF_WOUT + SZ_WOUT, OFF_DN1 = OFF_GU1 + SZ_GU, OFF_GU2 = OFF_DN1 + SZ_DN, OFF_DN2 = OFF_GU2 + SZ_GU;
constexpr size_t OFF_STATES = OFF_GU1, SZ_STATES = (size_t)NCHUNK * 32 * 8192 * 2;
constexpr size_t OFF_MISC = ((OFF_STATES + SZ_STATES > OFF_DN2 + SZ_DN ? OFF_STATES + SZ_STATES : OFF_DN2 + SZ_DN) + 255) & ~(size_t)255;
constexpr size_t OFF_CTL = OFF_MISC, OFF_HMETA = OFF_CTL + 4096, OFF_DEC = OFF_HMETA + (size_t)144 * DM * 4, OFF_RSTD = OFF_DEC + (size_t)NCHUNK * 32 * 4 + 128,
                 OFF_DT = OFF_RSTD + (size_t)ROWSP * 2 * 4, OFF_B = OFF_DT + (size_t)ROWSP * 32 * 4;
constexpr size_t SZ_B = (size_t)ROWSP * DM * 2;
constexpr size_t OFF_C = OFF_B + SZ_B;
constexpr size_t OFF_Q = OFF_C, OFF_Z = OFF_Q + (size_t)ROWSP * 1024 * 2, OFF_XBC = OFF_Z + (size_t)ROWSP * 1024 * 2, OFF_KP = OFF_XBC + (size_t)ROWSP * 1536 * 2,
                 OFF_VT = OFF_KP + (size_t)KVPOS * 256 * 2, OFF_END = OFF_VT + (size_t)KVPOS * 256 * 2;
constexpr size_t OFF_HID = OFF_C, OFF_MO = OFF_C;
constexpr size_t OFF_BAR = OFF_RSTD;
static_assert((size_t)3456 * 4 <= (size_t)ROWSP * 2 * 4 && OFF_RSTD % 256 == 0, "barrier words");
static_assert((size_t)16640 * FF * 2 <= OFF_END - OFF_C, "hidden overlay");
static_assert(OFF_END <= 596000000ull, "workspace budget");
static_assert(OFF_MISC % 256 == 0 && OFF_B % 256 == 0 && OFF_DT % 16 == 0 && OFF_RSTD % 8 == 0, "align");

constexpr int LDS_BYTES = 136 * 1024;
constexpr int MISC_LDS = 131072;

struct Params { const float* in[25]; float* out; unsigned char* ws; int ph_lo, ph_hi; };

__device__ __forceinline__ unsigned f2bf(float f) { unsigned u = __builtin_bit_cast(unsigned, f); return (u + 0x7fffu + ((u >> 16) & 1u)) >> 16; }
__device__ __forceinline__ unsigned pk2(float lo, float hi) { return f2bf(lo) | (f2bf(hi) << 16); }
__device__ __forceinline__ float bf2f(bf16_t b) { return __builtin_bit_cast(float, (unsigned)b << 16); }
__device__ __forceinline__ float bflo(unsigned u) { return __builtin_bit_cast(float, u << 16); }
__device__ __forceinline__ float bfhi(unsigned u) { return __builtin_bit_cast(float, u & 0xffff0000u); }
__device__ __forceinline__ unsigned cvt_pk_bf16(float lo, float hi) { unsigned r; asm volatile("v_cvt_pk_bf16_f32 %0, %1, %2" : "=v"(r) : "v"(lo), "v"(hi)); return r; }
__device__ __forceinline__ float wave_sum(float v) {
#pragma unroll
    for (int o = 1; o < 64; o <<= 1) v += __shfl_xor(v, o);
    return v;
}
__device__ __forceinline__ float silu_f(float x) { return x * __builtin_amdgcn_rcpf(1.f + __expf(-x)); }
#define LDS_WAIT() asm volatile("s_waitcnt lgkmcnt(0)" ::: "memory")
__device__ __forceinline__ float shfl_up_l(float v, int o, int lane) { int src = lane - o; src = src < 0 ? lane : src; return __builtin_bit_cast(float, __builtin_amdgcn_ds_bpermute(src << 2, __builtin_bit_cast(int, v))); }
__device__ __forceinline__ float shfl_idx_l(float v, int src) { return __builtin_bit_cast(float, __builtin_amdgcn_ds_bpermute(src << 2, __builtin_bit_cast(int, v))); }

__device__ __forceinline__ int seq_base(int s) { return s == 0 ? 0 : 16384 + (s - 1) * 2048; }
__device__ __forceinline__ int seq_L(int s) { return s == 0 ? 16400 : 2064; }
__device__ __forceinline__ int seq_Lpad(int s) { return s == 0 ? 16512 : 2176; }
__device__ __forceinline__ int seq_koff(int s) { return s == 0 ? 0 : 16512 + (s - 1) * 2176; }
__device__ __forceinline__ int pos2row(int s, int pos) { return pos < 16 ? NTOKR + 16 * s + pos : seq_base(s) + pos - 16; }
__device__ __forceinline__ void row2sp(int r, int& s, int& pos) {
    if (r < 16384) { s = 0; pos = r + 16; }
    else if (r < NTOKR) { const int q = r - 16384; s = 1 + (q >> 11); pos = (q & 2047) + 16; }
    else { const int q = r - NTOKR; s = q >> 4; pos = q & 15; }
}
__device__ __forceinline__ const float* h0row(const Params& p, int r) {
    return r < 16384 ? p.in[0] + (size_t)r * DM : (r < NTOKR ? p.in[1] + (size_t)(r - 16384) * DM : p.in[2] + (size_t)((r - NTOKR) & 15) * DM);
}
__device__ __forceinline__ float* hrow(const Params& p, int r) {
    return r < NTOKR ? p.out + (size_t)r * DM : (float*)(p.ws + OFF_HMETA) + (size_t)(r - NTOKR) * DM;
}

namespace pg8 {
constexpr int BM = 256, BK = 64, HALF = 128, HTB = HALF * BK * 2, STAGE_BYTES = 8 * HTB, NXCD = 8, WGM = 8;
__device__ __forceinline__ int lds_byte(int r, int c) { const int st = (r >> 4) * 2 + (c >> 5), rr = r & 15, cc = c & 31, ob = rr * 64 + cc * 2; return st * 1024 + (ob ^ (((ob >> 9) & 1) << 5)); }
__device__ __forceinline__ void stage_rc(int b, int& R, int& C) { const int st = b / 1024, sb = b % 1024, swz = sb ^ (((sb >> 9) & 1) << 5); R = (st >> 1) * 16 + swz / 64; C = (st & 1) * 32 + (swz % 64) / 2; }
__device__ __forceinline__ int perm32(int rho) { const int n = rho >> 4, i = rho & 15; return 8 * (i >> 2) + 4 * n + (i & 3); }
struct Unit { int pm, pn; };
struct Gemm { const bf16_t* A; const bf16_t* Bt; int M, N, K; };
struct StaticOrder {
    int nM, nN, nwg, G, c;
    __device__ void init(int M, int N, int G_, int c_) { nM = M / BM; nN = N / BM; nwg = nM * nN; G = G_; c = c_; }
    __device__ bool next(int i, Unit& u) const {
        const long L = (long)i * G + c; if (L >= nwg) return false;
        int wgid = (int)L; { const int q = nwg / NXCD, r = nwg % NXCD, xcd = wgid % NXCD, off = wgid / NXCD; wgid = (xcd < r ? xcd * (q + 1) : r * (q + 1) + (xcd - r) * q) + off; }
        const int nig = WGM * nN, gid = wgid / nig, fm = gid * WGM, gsz = (nM - fm) < WGM ? (nM - fm) : WGM;
        u.pm = fm + ((wgid % nig) % gsz); u.pn = (wgid % nig) / gsz; return true;
    }
};
template <class Epi>
__device__ __forceinline__ void gemm_phase(LAS unsigned char* lds, const Gemm g, const StaticOrder& S, const Epi& E, const int tid) {
    const int wid = __builtin_amdgcn_readfirstlane(tid >> 6), lane = tid & 63, wr = wid >> 2, wc = wid & 3, fr = lane & 15, fq = lane >> 4;
    const int K = g.K, nt = K / BK;
    unsigned voffA[2], voffB[2];
#pragma unroll
    for (int i = 0; i < 2; ++i) { int R, C; stage_rc(tid * 16 + i * 8192, R, C); const int Rb = (R & ~31) + perm32(R & 31);
        voffA[i] = (unsigned)(R * K + C) * 2u; voffB[i] = (unsigned)(Rb * K + C) * 2u; }
    const size_t kstep = (size_t)(BK * 2);
    const size_t hstep = (size_t)HALF * K * 2;
    const size_t tstep = 2 * hstep;
    const unsigned ldsw = (unsigned)wid * 1024u;
    const int aoff = lds_byte(wr * 64 + fr, fq * 8), boff = lds_byte(wc * 32 + fr, fq * 8);
#define PG8_SA(b, h) (((b) * 2 + (h)) * HTB)
#define PG8_SB(b, h) ((4 + (b) * 2 + (h)) * HTB)
#define PG8_STAGE(bufoff, gbase, voff) do { _Pragma("unroll") for (int _i = 0; _i < 2; ++_i) \
        __builtin_amdgcn_global_load_lds((const unsigned*)((const char*)(gbase) + (voff)[_i]), (LAS unsigned*)(lds + (bufoff) + ldsw + _i * 8192), 16, 0, 0); } while (0)
#define PG8_LDA(dst, b, h) do { _Pragma("unroll") for (int m = 0; m < 4; ++m) _Pragma("unroll") for (int k = 0; k < 2; ++k) dst[m][k] = *(const LAS bf16x8*)(lds + PG8_SA(b, h) + aoff + m * 2048 + k * 1024); } while (0)
#define PG8_LDB(dst, b, h) do { _Pragma("unroll") for (int n = 0; n < 2; ++n) _Pragma("unroll") for (int k = 0; k < 2; ++k) dst[n][k] = *(const LAS bf16x8*)(lds + PG8_SB(b, h) + boff + n * 2048 + k * 1024); } while (0)
#define PG8_MMA(ai, bj, At, Bt) do { __builtin_amdgcn_s_setprio(1); _Pragma("unroll") for (int m = 0; m < 4; ++m) _Pragma("unroll") for (int n = 0; n < 2; ++n) _Pragma("unroll") for (int k = 0; k < 2; ++k) \
        acc[ai][bj][m][n] = __builtin_amdgcn_mfma_f32_16x16x32_bf16(Bt[n][k], At[m][k], acc[ai][bj][m][n], 0, 0, 0); __builtin_amdgcn_s_setprio(0); } while (0)
#define PG8_WAIT_V(n) asm volatile("s_waitcnt vmcnt(" #n ")" ::: "memory")
#define PG8_WAIT_L(n) asm volatile("s_waitcnt lgkmcnt(" #n ")" ::: "memory")
#define PG8_BAR __builtin_amdgcn_s_barrier()
#define PG8_SCHED __builtin_amdgcn_sched_barrier(0)
    Unit cur, nxt; int ui = 0;
    if (!S.next(0, cur)) return;
    f32x4 acc[2][2][4][2];
#pragma unroll
    for (int a = 0; a < 2; ++a)
#pragma unroll
        for (int b = 0; b < 2; ++b)
#pragma unroll
            for (int m = 0; m < 4; ++m)
#pragma unroll
                for (int n = 0; n < 2; ++n) acc[a][b][m][n] = (f32x4){0.f, 0.f, 0.f, 0.f};
    bf16x8 At[4][2], B0[2][2], B1[2][2];
    const char* cA = (const char*)g.A + (size_t)cur.pm * tstep; const char* cB = (const char*)g.Bt + (size_t)cur.pn * tstep;
    PG8_STAGE(PG8_SB(0, 0), cB, voffB); PG8_STAGE(PG8_SB(0, 1), cB + hstep, voffB); PG8_STAGE(PG8_SA(0, 0), cA, voffA); PG8_STAGE(PG8_SA(0, 1), cA + hstep, voffA);
    if (wr == 1) PG8_BAR;
    PG8_WAIT_V(2); PG8_BAR;
    PG8_STAGE(PG8_SB(1, 0), cB + kstep, voffB); PG8_STAGE(PG8_SA(1, 0), cA + kstep, voffA); PG8_STAGE(PG8_SB(1, 1), cB + hstep + kstep, voffB);
    PG8_WAIT_V(6); PG8_BAR;
    for (;;) {
        const bool has_next = S.next(ui + 1, nxt);
        const char* nA = has_next ? (const char*)g.A + (size_t)nxt.pm * tstep : cA; const char* nB = has_next ? (const char*)g.Bt + (size_t)nxt.pn * tstep : cB;
        for (int t = 0; t < nt; t += 2) {
            const bool last = (t == nt - 2);
            const char* a1 = cA + (size_t)(t + 1) * kstep;
            const char* a2 = last ? nA : cA + (size_t)(t + 2) * kstep; const char* b2 = last ? nB : cB + (size_t)(t + 2) * kstep;
            const char* a3 = a2 + kstep; const char* b3 = b2 + kstep;
            PG8_LDB(B0, 0, 0); PG8_LDB(B1, 0, 1); PG8_SCHED; PG8_LDA(At, 0, 0); PG8_STAGE(PG8_SA(1, 1), a1 + hstep, voffA);
            PG8_WAIT_V(8); PG8_WAIT_L(0); PG8_BAR; PG8_MMA(0, 0, At, B0); PG8_MMA(0, 1, At, B1); PG8_BAR; PG8_SCHED;
            PG8_LDA(At, 0, 1); PG8_STAGE(PG8_SB(0, 0), b2, voffB); PG8_STAGE(PG8_SB(0, 1), b2 + hstep, voffB); PG8_STAGE(PG8_SA(0, 0), a2, voffA);
            PG8_WAIT_V(8); PG8_WAIT_L(0); PG8_BAR; PG8_MMA(1, 0, At, B0); PG8_MMA(1, 1, At, B1); PG8_BAR; PG8_SCHED;
            PG8_LDB(B0, 1, 0); PG8_LDB(B1, 1, 1); PG8_SCHED; PG8_LDA(At, 1, 0); PG8_STAGE(PG8_SA(0, 1), a2 + hstep, voffA);
            PG8_WAIT_V(8); PG8_WAIT_L(0); PG8_BAR; PG8_MMA(0, 0, At, B0); PG8_MMA(0, 1, At, B1); PG8_BAR; PG8_SCHED;
            PG8_LDA(At, 1, 1); PG8_STAGE(PG8_SB(1, 0), b3, voffB); PG8_STAGE(PG8_SB(1, 1), b3 + hstep, voffB); PG8_STAGE(PG8_SA(1, 0), a3, voffA);
            PG8_WAIT_V(8); PG8_WAIT_L(0); PG8_BAR; PG8_MMA(1, 0, At, B0); PG8_MMA(1, 1, At, B1); PG8_BAR; PG8_SCHED;
        }
        if (wr == 0) PG8_BAR;
        E(acc, cur, wr, wc, fr, fq);
        if (!has_next) break;
#pragma unroll
        for (int a = 0; a < 2; ++a)
#pragma unroll
            for (int b = 0; b < 2; ++b)
#pragma unroll
                for (int m = 0; m < 4; ++m)
#pragma unroll
                    for (int n = 0; n < 2; ++n) acc[a][b][m][n] = (f32x4){0.f, 0.f, 0.f, 0.f};
        cur = nxt; cA = nA; cB = nB; ++ui;
        if (wr == 1) PG8_BAR;
    }
    PG8_WAIT_V(0);
    PG8_BAR;
#undef PG8_SA
#undef PG8_SB
#undef PG8_STAGE
#undef PG8_LDA
#undef PG8_LDB
#undef PG8_MMA
#undef PG8_WAIT_V
#undef PG8_WAIT_L
#undef PG8_BAR
#undef PG8_SCHED
}

struct EpiStore {
    bf16_t* O; int ldc;
    __device__ __forceinline__ void operator()(const f32x4 (&acc)[2][2][4][2], const Unit& u, int wr, int wc, int fr, int fq) const {
        const int row0 = u.pm * BM + wr * 64 + fr, col0 = u.pn * BM + wc * 32 + 8 * fq;
#pragma unroll
        for (int ai = 0; ai < 2; ++ai)
#pragma unroll
            for (int m = 0; m < 4; ++m) { bf16_t* rowp = O + (size_t)(row0 + ai * HALF + m * 16) * ldc + col0;
#pragma unroll
                for (int bj = 0; bj < 2; ++bj) { const f32x4 v0 = acc[ai][bj][m][0], v1 = acc[ai][bj][m][1];
                    u32x4 w; w.x = cvt_pk_bf16(v0[0], v0[1]); w.y = cvt_pk_bf16(v0[2], v0[3]); w.z = cvt_pk_bf16(v1[0], v1[1]); w.w = cvt_pk_bf16(v1[2], v1[3]);
                    *(u32x4*)(rowp + bj * HALF) = w; } }
    }
};
struct EpiSwiglu {
    bf16_t* O;
    __device__ __forceinline__ void operator()(const f32x4 (&acc)[2][2][4][2], const Unit& u, int wr, int wc, int fr, int fq) const {
        const int row0 = u.pm * BM + wr * 64 + fr, col0 = u.pn * HALF + wc * 32 + 8 * fq;
#pragma unroll
        for (int ai = 0; ai < 2; ++ai)
#pragma unroll
            for (int m = 0; m < 4; ++m) { bf16_t* rowp = O + (size_t)(row0 + ai * HALF + m * 16) * FF + col0;
                float o[8];
#pragma unroll
                for (int n = 0; n < 2; ++n)
#pragma unroll
                    for (int i = 0; i < 4; ++i) { const float gt = acc[ai][0][m][n][i], up = acc[ai][1][m][n][i]; o[4 * n + i] = silu_f(gt) * up; }
                u32x4 w; w.x = cvt_pk_bf16(o[0], o[1]); w.y = cvt_pk_bf16(o[2], o[3]); w.z = cvt_pk_bf16(o[4], o[5]); w.w = cvt_pk_bf16(o[6], o[7]);
                *(u32x4*)rowp = w; }
    }
};
struct EpiInproj {
    bf16_t *Q, *KP, *VT, *Z, *XBC; float* DT; const float* dt_bias;
    __device__ __forceinline__ void operator()(const f32x4 (&acc)[2][2][4][2], const Unit& u, int wr, int wc, int fr, int fq) const {
        const int pn = u.pn, row0 = u.pm * BM + wr * 64 + fr, c0 = wc * 32 + 8 * fq;
        if (pn == 4 || pn == 5) {
#pragma unroll
            for (int ai = 0; ai < 2; ++ai)
#pragma unroll
                for (int m = 0; m < 4; ++m) {
                    int r = row0 + ai * HALF + m * 16; asm volatile("" : "+v"(r));
                    if (r < ROWS) {
                        int s, pos; row2sp(r, s, pos); const unsigned Lp = (unsigned)seq_Lpad(s), kb = (unsigned)seq_koff(s) * 4u;
#pragma unroll
                        for (int bj = 0; bj < 2; ++bj) { const f32x4 v0 = acc[ai][bj][m][0], v1 = acc[ai][bj][m][1];
                            const unsigned c = (unsigned)(bj * HALF + c0), kvh = c >> 6, d = c & 63u;
                            if (pn == 4) { u32x4 w; w.x = cvt_pk_bf16(v0[0], v0[1]); w.y = cvt_pk_bf16(v0[2], v0[3]); w.z = cvt_pk_bf16(v1[0], v1[1]); w.w = cvt_pk_bf16(v1[2], v1[3]);
                                *(u32x4*)(KP + (size_t)((kb + kvh * Lp + (unsigned)pos) * 64u + d)) = w; }
                            else { unsigned vo = kb * 64u + (kvh * 64u + d) * Lp + (unsigned)pos;
#pragma unroll
                                for (int i = 0; i < 4; ++i) { VT[vo] = (bf16_t)f2bf(v0[i]); vo += Lp; }
#pragma unroll
                                for (int i = 0; i < 4; ++i) { VT[vo] = (bf16_t)f2bf(v1[i]); vo += Lp; } } }
                    }
                    __builtin_amdgcn_sched_barrier(0);
                }
        } else if (pn == 16) {
            if (wc == 0) {
#pragma unroll
                for (int ai = 0; ai < 2; ++ai)
#pragma unroll
                    for (int m = 0; m < 4; ++m) { const int r = row0 + ai * HALF + m * 16;
                        const f32x4 v0 = acc[ai][0][m][0], v1 = acc[ai][0][m][1]; float* dp = DT + (size_t)r * 32 + c0;
#pragma unroll
                        for (int i = 0; i < 4; ++i) { float x0 = v0[i] + dt_bias[c0 + i], x1 = v1[i] + dt_bias[c0 + 4 + i];
                            dp[i] = x0 > 20.f ? x0 : log1pf(__expf(x0)); dp[4 + i] = x1 > 20.f ? x1 : log1pf(__expf(x1)); }
                        __builtin_amdgcn_sched_barrier(0); }
            }
        } else {
            bf16_t* base; int ld, ct;
            if (pn < 4) { base = Q; ld = 1024; ct = pn; } else if (pn < 10) { base = Z; ld = 1024; ct = pn - 6; } else { base = XBC; ld = 1536; ct = pn - 10; }
            base += ct * BM + c0;
#pragma unroll
            for (int ai = 0; ai < 2; ++ai)
#pragma unroll
                for (int m = 0; m < 4; ++m) { bf16_t* rowp = base + (size_t)(row0 + ai * HALF + m * 16) * ld;
#pragma unroll
                    for (int bj = 0; bj < 2; ++bj) { const f32x4 v0 = acc[ai][bj][m][0], v1 = acc[ai][bj][m][1];
                        u32x4 w; w.x = cvt_pk_bf16(v0[0], v0[1]); w.y = cvt_pk_bf16(v0[2], v0[3]); w.z = cvt_pk_bf16(v1[0], v1[1]); w.w = cvt_pk_bf16(v1[2], v1[3]);
                        *(u32x4*)(rowp + bj * HALF) = w; } }
        }
    }
};
}

__device__ __forceinline__ void transpose_item(const float* W, int K, int N, bf16_t* WT, int drow0, int k0, int n0, LAS float* scr, int lane) {
#pragma unroll
    for (int i = 0; i < 32; ++i) { const int kk = 2 * i + (lane >> 5); scr[kk * 33 + (lane & 31)] = __builtin_nontemporal_load(&W[(size_t)(k0 + kk) * N + n0 + (lane & 31)]); }
    LDS_WAIT();
    const int c = lane & 7;
#pragma unroll
    for (int j = 0; j < 4; ++j) { const int n = (lane >> 3) + 8 * j; const LAS float* s = scr + (8 * c) * 33 + n;
        u32x4 o; o.x = pk2(s[0 * 33], s[1 * 33]); o.y = pk2(s[2 * 33], s[3 * 33]); o.z = pk2(s[4 * 33], s[5 * 33]); o.w = pk2(s[6 * 33], s[7 * 33]);
        *(u32x4*)(WT + (size_t)(drow0 + n) * K + k0 + 8 * c) = o; }
    LDS_WAIT();
}
__device__ __forceinline__ void convert_ffn(const float* Wg, const float* Wu, const float* Wd, bf16_t* GU, bf16_t* DN, LAS float* scr, int gw, int NGW, int lane) {
    constexpr int I1 = (DM / 64) * (FF / 32);
    for (int it = gw; it < 3 * I1; it += NGW) {
        if (it < 2 * I1) { const int up = it >= I1, r = it - up * I1, kb = r / (FF / 32), nb = r % (FF / 32), n0 = nb * 32;
            transpose_item(up ? Wu : Wg, DM, FF, GU, 256 * (n0 >> 7) + up * 128 + (n0 & 127), kb * 64, n0, scr, lane); }
        else { const int r = it - 2 * I1, kb = r / (DM / 32), nb = r % (DM / 32); transpose_item(Wd, FF, DM, DN, nb * 32, kb * 64, nb * 32, scr, lane); }
    }
}

__device__ __forceinline__ void convert_ffn_dyn(const float* Wg, const float* Wu, const float* Wd, bf16_t* GU, bf16_t* DN, LAS unsigned char* lds, unsigned* ctr, int max_batches, int tid, int wave, int lane) {
    constexpr int I1 = (DM / 64) * (FF / 32), NB = 3 * I1 / 8;
    LAS int* MISC = (LAS int*)(lds + MISC_LDS); LAS float* scr = (LAS float*)(lds + wave * 16384);
    for (int n = 0; n < max_batches; ++n) {
        if (tid == 0) MISC[0] = (int)atomicAdd(ctr, 1u);
        __syncthreads();
        const int b = __builtin_amdgcn_readfirstlane(MISC[0]);
        __syncthreads();
        if (b >= NB) break;
        const int it = b * 8 + wave;
        if (it < 2 * I1) { const int up = it >= I1, r = it - up * I1, kb = r / (FF / 32), nb = r % (FF / 32), n0 = nb * 32;
            transpose_item(up ? Wu : Wg, DM, FF, GU, 256 * (n0 >> 7) + up * 128 + (n0 & 127), kb * 64, n0, scr, lane); }
        else { const int r = it - 2 * I1, kb = r / (DM / 32), nb = r % (DM / 32); transpose_item(Wd, FF, DM, DN, nb * 32, kb * 64, nb * 32, scr, lane); }
    }
}

template <int MODE>
__device__ __forceinline__ void row_load(const Params& p, int r, int lane, const bf16_t* Dsrc, f32x4 (&h)[8], u32x2 (&dw)[8]) {
    if (r >= ROWS || (MODE >= 2 && r >= NTOKR)) return;
    const f32x4* hs = (const f32x4*)((MODE <= 1) ? h0row(p, r) : (const float*)hrow(p, r));
#pragma unroll
    for (int j = 0; j < 8; ++j) h[j] = __builtin_nontemporal_load(&hs[lane + 64 * j]);
    if (MODE >= 1) { const u32x2* dp = (const u32x2*)(Dsrc + (size_t)r * DM);
#pragma unroll
        for (int j = 0; j < 8; ++j) dw[j] = __builtin_nontemporal_load(&dp[lane + 64 * j]); }
}
template <int MODE>
__device__ __forceinline__ void row_finish(const Params& p, int r, int lane, const float* gpost, const float* gnext, bf16_t* U, float coef, f32x4 (&h)[8], const u32x2 (&dw)[8]) {
    if (r >= ROWSP) return;
    if (r >= ROWS) { if (MODE != 3) { u32x4* up = (u32x4*)(U + (size_t)r * DM);
#pragma unroll
            for (int j = 0; j < 4; ++j) up[lane + 64 * j] = (u32x4){0u, 0u, 0u, 0u}; } return; }
    if (MODE >= 2 && r >= NTOKR) return;
    if (MODE >= 1) {
        f32x4 d[8]; float ss = 0.f;
#pragma unroll
        for (int j = 0; j < 8; ++j) { const u32x2 w = dw[j]; d[j] = (f32x4){bflo(w.x), bfhi(w.x), bflo(w.y), bfhi(w.y)};
            ss += (d[j].x * d[j].x + d[j].y * d[j].y) + (d[j].z * d[j].z + d[j].w * d[j].w); }
        ss = wave_sum(ss);
        const float rs = rsqrtf(ss * (1.f / DM) + EPS) * coef;
        f32x4* hd = (f32x4*)hrow(p, r);
#pragma unroll
        for (int j = 0; j < 8; ++j) { const f32x4 g = ((const f32x4*)gpost)[lane + 64 * j]; h[j] = h[j] + d[j] * g * rs; __builtin_nontemporal_store(h[j], &hd[lane + 64 * j]); }
    }
    if (MODE != 3) {
        float s2 = 0.f;
#pragma unroll
        for (int j = 0; j < 8; ++j) s2 += (h[j].x * h[j].x + h[j].y * h[j].y) + (h[j].z * h[j].z + h[j].w * h[j].w);
        s2 = wave_sum(s2);
        const float rs2 = rsqrtf(s2 * (1.f / DM) + EPS);
        u32x2* up = (u32x2*)(U + (size_t)r * DM);
#pragma unroll
        for (int j = 0; j < 8; ++j) { const f32x4 g = ((const f32x4*)gnext)[lane + 64 * j]; const f32x4 v = h[j] * g * rs2;
            u32x2 w; w.x = pk2(v.x, v.y); w.y = pk2(v.z, v.w); up[lane + 64 * j] = w; }
    }
}
template <int MODE>
__device__ __forceinline__ void row_pass(const Params& p, int wave, int lane, const float* gpost, const float* gnext, const bf16_t* Dsrc, bf16_t* U, float coef, int rbeg) {
    const int gw = blockIdx.x * 8 + wave, NGW = gridDim.x * 8;
    for (int r = rbeg + gw; r < ROWSP; r += 2 * NGW) {
        f32x4 ha[8], hb[8]; u32x2 da[8], db[8];
        row_load<MODE>(p, r, lane, Dsrc, ha, da);
        row_load<MODE>(p, r + NGW, lane, Dsrc, hb, db);
        row_finish<MODE>(p, r, lane, gpost, gnext, U, coef, ha, da);
        row_finish<MODE>(p, r + NGW, lane, gpost, gnext, U, coef, hb, db);
    }
}
constexpr int RP_CHUNKS = 16384 / 64;
template <int MODE>
__device__ __forceinline__ void row_pass_chunks(const Params& p, LAS int* MISC, unsigned* ctr, int max_chunks, int tid, int wave, int lane, const float* gpost, const float* gnext, const bf16_t* Dsrc, bf16_t* U, float coef, int chunk0 = 0) {
    for (int n = 0; n < max_chunks; ++n) {
        if (tid == 0) MISC[0] = (int)atomicAdd(ctr, 1u);
        __syncthreads();
        const int c = __builtin_amdgcn_readfirstlane(MISC[0]);
        __syncthreads();
        if (c >= RP_CHUNKS) break;
        const int r0 = (chunk0 + c) * 64 + wave * 8;
#pragma unroll 1
        for (int k = 0; k < 8; k += 2) {
            f32x4 ha[8], hb[8]; u32x2 da[8], db[8];
            row_load<MODE>(p, r0 + k, lane, Dsrc, ha, da);
            row_load<MODE>(p, r0 + k + 1, lane, Dsrc, hb, db);
            row_finish<MODE>(p, r0 + k, lane, gpost, gnext, U, coef, ha, da);
            row_finish<MODE>(p, r0 + k + 1, lane, gpost, gnext, U, coef, hb, db);
        }
    }
}

__device__ __forceinline__ void prep_vec(bf16_t* vp, int j, const float* gain, const float (&cs)[8], const float (&sn)[8], float scale) {
    u32x2 w[4]; float x[16];
#pragma unroll
    for (int q = 0; q < 4; ++q) { w[q] = *(const u32x2*)(vp + 16 * q + 4 * j); x[4 * q] = bflo(w[q].x); x[4 * q + 1] = bfhi(w[q].x); x[4 * q + 2] = bflo(w[q].y); x[4 * q + 3] = bfhi(w[q].y); }
    float ss = 0.f;
#pragma unroll
    for (int i = 0; i < 16; ++i) ss += x[i] * x[i];
    ss += __shfl_xor(ss, 1); ss += __shfl_xor(ss, 2);
    const float rs = rsqrtf(ss * (1.f / 64.f) + EPS);
#pragma unroll
    for (int q = 0; q < 4; ++q) { const f32x4 g = *(const f32x4*)(gain + 16 * q + 4 * j);
        x[4 * q] *= rs * g.x; x[4 * q + 1] *= rs * g.y; x[4 * q + 2] *= rs * g.z; x[4 * q + 3] *= rs * g.w; }
    float o[16];
#pragma unroll
    for (int ax = 0; ax < 2; ++ax)
#pragma unroll
        for (int i = 0; i < 4; ++i) { const float a = x[8 * ax + i], b = x[8 * ax + 4 + i], c = cs[4 * ax + i], s_ = sn[4 * ax + i];
            o[8 * ax + i] = (a * c - b * s_) * scale; o[8 * ax + 4 + i] = (b * c + a * s_) * scale; }
#pragma unroll
    for (int q = 0; q < 4; ++q) { u32x2 r; r.x = pk2(o[4 * q], o[4 * q + 1]); r.y = pk2(o[4 * q + 2], o[4 * q + 3]); *(u32x2*)(vp + 16 * q + 4 * j) = r; }
}
constexpr int PREP_CHUNK = 64, PREP_NCHUNK = (ROWS + PREP_CHUNK - 1) / PREP_CHUNK;
__device__ __forceinline__ void prep_rows(const Params& p, int chunk, int wave, int lane) {
    bf16_t* Q = (bf16_t*)(p.ws + OFF_Q); bf16_t* KP = (bf16_t*)(p.ws + OFF_KP);
    const int j = lane & 3, hl = lane >> 2;
    float invf[4];
#pragma unroll
    for (int i = 0; i < 4; ++i) invf[i] = exp2f(-(float)(4 * j + i) * (13.287712379549449f / 16.f));
    for (int k = 0; k < PREP_CHUNK / 8; ++k) {
        const int r = chunk * PREP_CHUNK + k * 8 + wave;
        if (r >= ROWS) break;
        int s, pos; row2sp(r, s, pos);
        float cs[8], sn[8];
#pragma unroll
        for (int i = 0; i < 8; ++i) { cs[i] = 1.f; sn[i] = 0.f; }
        if (pos >= 16) { const int ti = pos - 16; const float fr = (float)(ti >> 6), fc = (float)(ti & 63);
#pragma unroll
            for (int i = 0; i < 4; ++i) { const float a0 = fr * invf[i], a1 = fc * invf[i]; cs[i] = __cosf(a0); sn[i] = __sinf(a0); cs[4 + i] = __cosf(a1); sn[4 + i] = __sinf(a1); } }
        prep_vec(Q + (size_t)r * 1024 + hl * 64, j, p.in[15], cs, sn, QSCALE);
        if (hl < 4) { const int Lp = seq_Lpad(s); prep_vec(KP + ((size_t)seq_koff(s) * 4 + (size_t)hl * Lp + pos) * 64, j, p.in[16], cs, sn, 1.f); }
    }
}
__device__ __forceinline__ void prep_pads(const Params& p, int tid) {
    bf16_t* KP = (bf16_t*)(p.ws + OFF_KP); bf16_t* VT = (bf16_t*)(p.ws + OFF_VT);
    const int gt = blockIdx.x * 512 + tid, NT = gridDim.x * 512;
    for (int i = gt; i < NSEQ * 4 * 112 * 64; i += NT) {
        const int d = i & 63, q = i >> 6, pp = q % 112, sh = q / 112, s = sh >> 2, kvh = sh & 3;
        const int L = seq_L(s), Lp = seq_Lpad(s); const size_t kb = (size_t)seq_koff(s) * 4;
        KP[(kb + (size_t)kvh * Lp + L + pp) * 64 + d] = 0;
        VT[kb * 64 + (size_t)(kvh * 64 + d) * Lp + L + pp] = 0;
    }
}

constexpr int ATT_BIG = 512, ATT_UNITS = ATT_BIG + 16 + 1152;
constexpr int KPITCH = 72;
constexpr int VPITCH = 136;
__device__ __forceinline__ void attn_unit(unsigned char* ws, LAS unsigned char* lds, int s, int kvh, int qb, int hq, int nblk, int tid, int wave, int lane, const int FAST) {
    const int h = kvh * 4 + hq, L = seq_L(s), Lp = seq_Lpad(s), ntile = Lp >> 7;
    const GAS bf16_t* Q = (const GAS bf16_t*)(ws + OFF_Q);
    const GAS bf16_t* Kg = (const GAS bf16_t*)(ws + OFF_KP) + ((size_t)seq_koff(s) * 4 + (size_t)kvh * Lp) * 64;
    const GAS bf16_t* Vg = (const GAS bf16_t*)(ws + OFF_VT) + (size_t)seq_koff(s) * 4 * 64 + (size_t)kvh * 64 * Lp;
    GAS bf16_t* O = (GAS bf16_t*)(ws + OFF_B);
    const int l31 = lane & 31, qi = wave * 32 + l31, hi = lane >> 5;
    const bool qvalid = qb < nblk || qi < 16;
    const int row = qb < nblk ? seq_base(s) + qb * 256 + qi : NTOKR + 16 * s + (qi & 15);
    bf16x8 qf[4];
#pragma unroll
    for (int kk = 0; kk < 4; ++kk) qf[kk] = *(const GAS bf16x8*)(Q + (size_t)row * 1024 + h * 64 + 16 * kk + 8 * hi);
    LAS bf16_t* Ks = (LAS bf16_t*)lds;
    LAS bf16_t* Vs = (LAS bf16_t*)(lds + 2 * 128 * KPITCH * 2);
    const int sr = tid >> 3, sc = (tid & 7) * 8;
    const GAS bf16_t* kgp = Kg + (size_t)sr * 64 + sc;
    const GAS bf16_t* vgp = Vg + (size_t)sr * Lp + sc;
    u32x4 kreg0 = *(const GAS u32x4*)kgp, kreg1 = *(const GAS u32x4*)(kgp + 64 * 64), vreg0 = *(const GAS u32x4*)vgp, vreg1 = *(const GAS u32x4*)(vgp + 64);
    *(LAS u32x4*)(Ks + sr * KPITCH + sc) = kreg0; *(LAS u32x4*)(Ks + (sr + 64) * KPITCH + sc) = kreg1;
    *(LAS u32x4*)(Vs + sr * VPITCH + sc) = vreg0; *(LAS u32x4*)(Vs + sr * VPITCH + sc + 64) = vreg1;
    __syncthreads();
    f32x16 O0, O1, negm;
#pragma unroll
    for (int i = 0; i < 16; ++i) { O0[i] = 0.f; O1[i] = 0.f; negm[i] = 0.f; }
    float lsum = 0.f;
    for (int t = 0; t < ntile; ++t) {
        const int buf = t & 1;
        if (t + 1 < ntile) { const GAS bf16_t* kq = kgp + (size_t)(t + 1) * 128 * 64; const GAS bf16_t* vq = vgp + (t + 1) * 128;
            kreg0 = *(const GAS u32x4*)kq; kreg1 = *(const GAS u32x4*)(kq + 64 * 64); vreg0 = *(const GAS u32x4*)vq; vreg1 = *(const GAS u32x4*)(vq + 64); }
#pragma unroll
        for (int sub = 0; sub < 2; ++sub) {
            if (sub == 1 && t == ntile - 1) break;
            const LAS bf16_t* kt = Ks + buf * 128 * KPITCH + sub * 64 * KPITCH; const LAS bf16_t* vt = Vs + buf * 64 * VPITCH + sub * 64;
            f32x16 S0, S1;
            { const bf16x8 a0 = *(const LAS bf16x8*)(kt + l31 * KPITCH + 8 * hi), a1 = *(const LAS bf16x8*)(kt + (32 + l31) * KPITCH + 8 * hi);
              S0 = __builtin_amdgcn_mfma_f32_32x32x16_bf16(a0, qf[0], negm, 0, 0, 0); S1 = __builtin_amdgcn_mfma_f32_32x32x16_bf16(a1, qf[0], negm, 0, 0, 0); }
#pragma unroll
            for (int kk = 1; kk < 4; ++kk) {
                const bf16x8 a0 = *(const LAS bf16x8*)(kt + l31 * KPITCH + 16 * kk + 8 * hi), a1 = *(const LAS bf16x8*)(kt + (32 + l31) * KPITCH + 16 * kk + 8 * hi);
                S0 = __builtin_amdgcn_mfma_f32_32x32x16_bf16(a0, qf[kk], S0, 0, 0, 0); S1 = __builtin_amdgcn_mfma_f32_32x32x16_bf16(a1, qf[kk], S1, 0, 0, 0);
            }
            if (t == ntile - 1) { const int nv = L - t * 128 - sub * 64; asm volatile("" : "+v"(S0), "+v"(S1));
#pragma unroll
                for (int i = 0; i < 16; ++i) { const int key = (i & 3) + 8 * (i >> 2) + 4 * hi; if (key >= nv) S0[i] = -1e30f; if (key + 32 >= nv) S1[i] = -1e30f; } }
            if (!FAST) {
            float mx = fmaxf(fmaxf(S0[0], S0[1]), S0[2]);
#pragma unroll
            for (int i = 3; i < 15; i += 2) mx = fmaxf(fmaxf(mx, S0[i]), S0[i + 1]);
            mx = fmaxf(fmaxf(mx, S0[15]), S1[0]);
#pragma unroll
            for (int i = 1; i < 15; i += 2) mx = fmaxf(fmaxf(mx, S1[i]), S1[i + 1]);
            mx = fmaxf(mx, S1[15]);
            const bool first = (t == 0 && sub == 0);
            if (__any(first || mx > 8.f)) {
                asm volatile("; rescale");
                mx = fmaxf(mx, __shfl_xor(mx, 32));
                float delta = first ? mx : fmaxf(mx, 0.f), alpha = __builtin_amdgcn_exp2f(-delta);
                asm volatile("" : "+v"(delta), "+v"(alpha));
#pragma unroll
                for (int i = 0; i < 16; ++i) { S0[i] -= delta; S1[i] -= delta; O0[i] *= alpha; O1[i] *= alpha; negm[i] -= delta; }
                lsum *= alpha;
            }
            }
            float ps = 0.f;
#pragma unroll
            for (int i = 0; i < 16; ++i) { S0[i] = __builtin_amdgcn_exp2f(S0[i]); S1[i] = __builtin_amdgcn_exp2f(S1[i]); ps += S0[i] + S1[i]; }
            lsum += ps;
#pragma unroll
            for (int f = 0; f < 2; ++f)
#pragma unroll
                for (int k2 = 0; k2 < 2; ++k2) {
                    u32x4 pw;
                    if (f == 0) { pw.x = cvt_pk_bf16(S0[8 * k2 + 0], S0[8 * k2 + 1]); pw.y = cvt_pk_bf16(S0[8 * k2 + 2], S0[8 * k2 + 3]); pw.z = cvt_pk_bf16(S0[8 * k2 + 4], S0[8 * k2 + 5]); pw.w = cvt_pk_bf16(S0[8 * k2 + 6], S0[8 * k2 + 7]); }
                    else        { pw.x = cvt_pk_bf16(S1[8 * k2 + 0], S1[8 * k2 + 1]); pw.y = cvt_pk_bf16(S1[8 * k2 + 2], S1[8 * k2 + 3]); pw.z = cvt_pk_bf16(S1[8 * k2 + 4], S1[8 * k2 + 5]); pw.w = cvt_pk_bf16(S1[8 * k2 + 6], S1[8 * k2 + 7]); }
                    const bf16x8 pf = __builtin_bit_cast(bf16x8, pw);
                    const int k0 = 32 * f + 16 * k2 + 4 * hi;
                    const LAS bf16_t* v0p = vt + l31 * VPITCH + k0;
                    const LAS bf16_t* v1p = vt + (32 + l31) * VPITCH + k0;
                    const u32x2 a0l = *(const LAS u32x2*)v0p, a0h = *(const LAS u32x2*)(v0p + 8);
                    const u32x2 a1l = *(const LAS u32x2*)v1p, a1h = *(const LAS u32x2*)(v1p + 8);
                    const bf16x8 va0 = __builtin_bit_cast(bf16x8, (u32x4){a0l.x, a0l.y, a0h.x, a0h.y});
                    const bf16x8 va1 = __builtin_bit_cast(bf16x8, (u32x4){a1l.x, a1l.y, a1h.x, a1h.y});
                    O0 = __builtin_amdgcn_mfma_f32_32x32x16_bf16(va0, pf, O0, 0, 0, 0);
                    O1 = __builtin_amdgcn_mfma_f32_32x32x16_bf16(va1, pf, O1, 0, 0, 0);
                }
        }
        if (t + 1 < ntile) { LAS bf16_t* kd = Ks + (buf ^ 1) * 128 * KPITCH; LAS bf16_t* vd = Vs + (buf ^ 1) * 64 * VPITCH;
            *(LAS u32x4*)(kd + sr * KPITCH + sc) = kreg0; *(LAS u32x4*)(kd + (sr + 64) * KPITCH + sc) = kreg1;
            *(LAS u32x4*)(vd + sr * VPITCH + sc) = vreg0; *(LAS u32x4*)(vd + sr * VPITCH + sc + 64) = vreg1; }
        __syncthreads();
    }
    const float inv = 1.f / (lsum + __shfl_xor(lsum, 32));
    if (qvalid) {
        GAS bf16_t* op = O + (size_t)row * DM + h * 64 + 4 * hi;
#pragma unroll
        for (int g4 = 0; g4 < 4; ++g4) {
            u32x2 w0, w1;
            w0.x = cvt_pk_bf16(O0[4 * g4] * inv, O0[4 * g4 + 1] * inv); w0.y = cvt_pk_bf16(O0[4 * g4 + 2] * inv, O0[4 * g4 + 3] * inv);
            w1.x = cvt_pk_bf16(O1[4 * g4] * inv, O1[4 * g4 + 1] * inv); w1.y = cvt_pk_bf16(O1[4 * g4 + 2] * inv, O1[4 * g4 + 3] * inv);
            *(GAS u32x2*)(op + 8 * g4) = w0; *(GAS u32x2*)(op + 32 + 8 * g4) = w1;
        }
    }
}

__device__ __forceinline__ void attn_unit2(unsigned char* ws, LAS unsigned char* lds, int s, int kvh, int qb, int hp, int tid, int wave, int lane, const int FAST) {
    const int L = seq_L(s), Lp = seq_Lpad(s), ntile = Lp >> 7;
    const int h0 = kvh * 4 + hp * 2;
    const GAS bf16_t* Q = (const GAS bf16_t*)(ws + OFF_Q);
    const GAS bf16_t* Kg = (const GAS bf16_t*)(ws + OFF_KP) + ((size_t)seq_koff(s) * 4 + (size_t)kvh * Lp) * 64;
    const GAS bf16_t* Vg = (const GAS bf16_t*)(ws + OFF_VT) + (size_t)seq_koff(s) * 4 * 64 + (size_t)kvh * 64 * Lp;
    GAS bf16_t* O = (GAS bf16_t*)(ws + OFF_B);
    const int l31 = lane & 31, hi = lane >> 5, row = seq_base(s) + qb * 256 + wave * 32 + l31;
    bf16x8 qf[2][4];
#pragma unroll
    for (int nh = 0; nh < 2; ++nh)
#pragma unroll
        for (int kk = 0; kk < 4; ++kk) qf[nh][kk] = *(const GAS bf16x8*)(Q + (size_t)row * 1024 + (h0 + nh) * 64 + 16 * kk + 8 * hi);
    LAS bf16_t* Ks = (LAS bf16_t*)lds;
    LAS bf16_t* Vs = (LAS bf16_t*)(lds + 2 * 128 * KPITCH * 2);
    const int sr = tid >> 3, sc = (tid & 7) * 8;
    const GAS bf16_t* kgp = Kg + (size_t)sr * 64 + sc;
    const GAS bf16_t* vgp = Vg + (size_t)sr * Lp + sc;
    u32x4 kreg0 = *(const GAS u32x4*)kgp, kreg1 = *(const GAS u32x4*)(kgp + 64 * 64), vreg0 = *(const GAS u32x4*)vgp, vreg1 = *(const GAS u32x4*)(vgp + 64);
    *(LAS u32x4*)(Ks + sr * KPITCH + sc) = kreg0; *(LAS u32x4*)(Ks + (sr + 64) * KPITCH + sc) = kreg1;
    *(LAS u32x4*)(Vs + sr * VPITCH + sc) = vreg0; *(LAS u32x4*)(Vs + sr * VPITCH + sc + 64) = vreg1;
    __syncthreads();
    f32x16 Oa0, Oa1, Ob0, Ob1, nma, nmb;
#pragma unroll
    for (int i = 0; i < 16; ++i) { Oa0[i] = 0.f; Oa1[i] = 0.f; Ob0[i] = 0.f; Ob1[i] = 0.f; nma[i] = 0.f; nmb[i] = 0.f; }
    float lsa = 0.f, lsb = 0.f;
    for (int t = 0; t < ntile; ++t) {
        const int buf = t & 1;
        if (t + 1 < ntile) { const GAS bf16_t* kq = kgp + (size_t)(t + 1) * 128 * 64; const GAS bf16_t* vq = vgp + (t + 1) * 128;
            kreg0 = *(const GAS u32x4*)kq; kreg1 = *(const GAS u32x4*)(kq + 64 * 64); vreg0 = *(const GAS u32x4*)vq; vreg1 = *(const GAS u32x4*)(vq + 64); }
#pragma unroll
        for (int ks = 0; ks < 4; ++ks) {
            if (ks >= 1 && t == ntile - 1) break;
            const LAS bf16_t* kt = Ks + buf * 128 * KPITCH + ks * 32 * KPITCH + l31 * KPITCH + 8 * hi;
            const LAS bf16_t* vt = Vs + buf * 64 * VPITCH + ks * 32 + l31 * VPITCH + 4 * hi;
            const bf16x8 k0 = *(const LAS bf16x8*)(kt), k1 = *(const LAS bf16x8*)(kt + 16), k2 = *(const LAS bf16x8*)(kt + 32), k3 = *(const LAS bf16x8*)(kt + 48);
            f32x16 Sa = __builtin_amdgcn_mfma_f32_32x32x16_bf16(k0, qf[0][0], nma, 0, 0, 0);
            f32x16 Sb = __builtin_amdgcn_mfma_f32_32x32x16_bf16(k0, qf[1][0], nmb, 0, 0, 0);
            Sa = __builtin_amdgcn_mfma_f32_32x32x16_bf16(k1, qf[0][1], Sa, 0, 0, 0); Sb = __builtin_amdgcn_mfma_f32_32x32x16_bf16(k1, qf[1][1], Sb, 0, 0, 0);
            Sa = __builtin_amdgcn_mfma_f32_32x32x16_bf16(k2, qf[0][2], Sa, 0, 0, 0); Sb = __builtin_amdgcn_mfma_f32_32x32x16_bf16(k2, qf[1][2], Sb, 0, 0, 0);
            Sa = __builtin_amdgcn_mfma_f32_32x32x16_bf16(k3, qf[0][3], Sa, 0, 0, 0); Sb = __builtin_amdgcn_mfma_f32_32x32x16_bf16(k3, qf[1][3], Sb, 0, 0, 0);
            if (t == ntile - 1) { const int nv = L - t * 128 - ks * 32; asm volatile("" : "+v"(Sa), "+v"(Sb));
#pragma unroll
                for (int i = 0; i < 16; ++i) { const int key = (i & 3) + 8 * (i >> 2) + 4 * hi; if (key >= nv) { Sa[i] = -1e30f; Sb[i] = -1e30f; } } }
            if (!FAST) {
            float mxa = fmaxf(fmaxf(Sa[0], Sa[1]), Sa[2]), mxb = fmaxf(fmaxf(Sb[0], Sb[1]), Sb[2]);
#pragma unroll
            for (int i = 3; i < 15; i += 2) { mxa = fmaxf(fmaxf(mxa, Sa[i]), Sa[i + 1]); mxb = fmaxf(fmaxf(mxb, Sb[i]), Sb[i + 1]); }
            mxa = fmaxf(mxa, Sa[15]); mxb = fmaxf(mxb, Sb[15]);
            const bool first = (t == 0 && ks == 0);
            if (__any(first || mxa > 8.f || mxb > 8.f)) {
                asm volatile("; rescale");
                mxa = fmaxf(mxa, __shfl_xor(mxa, 32)); mxb = fmaxf(mxb, __shfl_xor(mxb, 32));
                const float da = first ? mxa : fmaxf(mxa, 0.f), db = first ? mxb : fmaxf(mxb, 0.f);
                float aa = __builtin_amdgcn_exp2f(-da), ab = __builtin_amdgcn_exp2f(-db);
                float da_ = da, db_ = db; asm volatile("" : "+v"(da_), "+v"(db_), "+v"(aa), "+v"(ab));
#pragma unroll
                for (int i = 0; i < 16; ++i) { Sa[i] -= da_; Sb[i] -= db_; Oa0[i] *= aa; Oa1[i] *= aa; Ob0[i] *= ab; Ob1[i] *= ab; nma[i] -= da_; nmb[i] -= db_; }
                lsa *= aa; lsb *= ab;
            }
            }
            float psa = 0.f, psb = 0.f;
#pragma unroll
            for (int i = 0; i < 16; ++i) { Sa[i] = __builtin_amdgcn_exp2f(Sa[i]); Sb[i] = __builtin_amdgcn_exp2f(Sb[i]); psa += Sa[i]; psb += Sb[i]; }
            lsa += psa; lsb += psb;
#pragma unroll
            for (int k2s = 0; k2s < 2; ++k2s) {
                const u32x2 a0l = *(const LAS u32x2*)(vt + 16 * k2s), a0h = *(const LAS u32x2*)(vt + 16 * k2s + 8);
                const u32x2 a1l = *(const LAS u32x2*)(vt + 32 * VPITCH + 16 * k2s), a1h = *(const LAS u32x2*)(vt + 32 * VPITCH + 16 * k2s + 8);
                const bf16x8 va0 = __builtin_bit_cast(bf16x8, (u32x4){a0l.x, a0l.y, a0h.x, a0h.y});
                const bf16x8 va1 = __builtin_bit_cast(bf16x8, (u32x4){a1l.x, a1l.y, a1h.x, a1h.y});
                u32x4 pa, pb;
                pa.x = cvt_pk_bf16(Sa[8 * k2s + 0], Sa[8 * k2s + 1]); pa.y = cvt_pk_bf16(Sa[8 * k2s + 2], Sa[8 * k2s + 3]); pa.z = cvt_pk_bf16(Sa[8 * k2s + 4], Sa[8 * k2s + 5]); pa.w = cvt_pk_bf16(Sa[8 * k2s + 6], Sa[8 * k2s + 7]);
                pb.x = cvt_pk_bf16(Sb[8 * k2s + 0], Sb[8 * k2s + 1]); pb.y = cvt_pk_bf16(Sb[8 * k2s + 2], Sb[8 * k2s + 3]); pb.z = cvt_pk_bf16(Sb[8 * k2s + 4], Sb[8 * k2s + 5]); pb.w = cvt_pk_bf16(Sb[8 * k2s + 6], Sb[8 * k2s + 7]);
                const bf16x8 pfa = __builtin_bit_cast(bf16x8, pa), pfb = __builtin_bit_cast(bf16x8, pb);
                Oa0 = __builtin_amdgcn_mfma_f32_32x32x16_bf16(va0, pfa, Oa0, 0, 0, 0); Ob0 = __builtin_amdgcn_mfma_f32_32x32x16_bf16(va0, pfb, Ob0, 0, 0, 0);
                Oa1 = __builtin_amdgcn_mfma_f32_32x32x16_bf16(va1, pfa, Oa1, 0, 0, 0); Ob1 = __builtin_amdgcn_mfma_f32_32x32x16_bf16(va1, pfb, Ob1, 0, 0, 0);
            }
        }
        if (t + 1 < ntile) { LAS bf16_t* kd = Ks + (buf ^ 1) * 128 * KPITCH; LAS bf16_t* vd = Vs + (buf ^ 1) * 64 * VPITCH;
            *(LAS u32x4*)(kd + sr * KPITCH + sc) = kreg0; *(LAS u32x4*)(kd + (sr + 64) * KPITCH + sc) = kreg1;
            *(LAS u32x4*)(vd + sr * VPITCH + sc) = vreg0; *(LAS u32x4*)(vd + sr * VPITCH + sc + 64) = vreg1; }
        __syncthreads();
    }
    const float inva = 1.f / (lsa + __shfl_xor(lsa, 32)), invb = 1.f / (lsb + __shfl_xor(lsb, 32));
    GAS bf16_t* op = O + (size_t)row * DM + h0 * 64 + 4 * hi;
#pragma unroll
    for (int g4 = 0; g4 < 4; ++g4) {
        u32x2 w0, w1, w2, w3;
        w0.x = cvt_pk_bf16(Oa0[4 * g4] * inva, Oa0[4 * g4 + 1] * inva); w0.y = cvt_pk_bf16(Oa0[4 * g4 + 2] * inva, Oa0[4 * g4 + 3] * inva);
        w1.x = cvt_pk_bf16(Oa1[4 * g4] * inva, Oa1[4 * g4 + 1] * inva); w1.y = cvt_pk_bf16(Oa1[4 * g4 + 2] * inva, Oa1[4 * g4 + 3] * inva);
        w2.x = cvt_pk_bf16(Ob0[4 * g4] * invb, Ob0[4 * g4 + 1] * invb); w2.y = cvt_pk_bf16(Ob0[4 * g4 + 2] * invb, Ob0[4 * g4 + 3] * invb);
        w3.x = cvt_pk_bf16(Ob1[4 * g4] * invb, Ob1[4 * g4 + 1] * invb); w3.y = cvt_pk_bf16(Ob1[4 * g4 + 2] * invb, Ob1[4 * g4 + 3] * invb);
        *(GAS u32x2*)(op + 8 * g4) = w0; *(GAS u32x2*)(op + 32 + 8 * g4) = w1; *(GAS u32x2*)(op + 64 + 8 * g4) = w2; *(GAS u32x2*)(op + 96 + 8 * g4) = w3;
    }
}

__device__ __forceinline__ void attn_unit2f(unsigned char* ws, LAS unsigned char* lds, int s, int kvh, int qb, int hp, int tid, int wave, int lane) {
    const int L = seq_L(s), Lp = seq_Lpad(s), ntile = Lp >> 7;
    const int h0 = kvh * 4 + hp * 2;
    const GAS bf16_t* Q = (const GAS bf16_t*)(ws + OFF_Q);
    const GAS bf16_t* Kg = (const GAS bf16_t*)(ws + OFF_KP) + ((size_t)seq_koff(s) * 4 + (size_t)kvh * Lp) * 64;
    const GAS bf16_t* Vg = (const GAS bf16_t*)(ws + OFF_VT) + (size_t)seq_koff(s) * 4 * 64 + (size_t)kvh * 64 * Lp;
    GAS bf16_t* O = (GAS bf16_t*)(ws + OFF_B);
    const int l31 = lane & 31, hi = lane >> 5, row = seq_base(s) + qb * 256 + wave * 32 + l31;
    bf16x8 qf[2][4];
#pragma unroll
    for (int nh = 0; nh < 2; ++nh)
#pragma unroll
        for (int kk = 0; kk < 4; ++kk) qf[nh][kk] = *(const GAS bf16x8*)(Q + (size_t)row * 1024 + (h0 + nh) * 64 + 16 * kk + 8 * hi);
    LAS bf16_t* Ks = (LAS bf16_t*)lds;
    LAS bf16_t* Vs = (LAS bf16_t*)(lds + 2 * 128 * KPITCH * 2);
    const int sr = tid >> 3, sc = (tid & 7) * 8;
    const GAS bf16_t* kgp = Kg + (size_t)sr * 64 + sc;
    const GAS bf16_t* vgp = Vg + (size_t)sr * Lp + sc;
    u32x4 kreg0 = *(const GAS u32x4*)kgp, kreg1 = *(const GAS u32x4*)(kgp + 64 * 64), vreg0 = *(const GAS u32x4*)vgp, vreg1 = *(const GAS u32x4*)(vgp + 64);
    *(LAS u32x4*)(Ks + sr * KPITCH + sc) = kreg0; *(LAS u32x4*)(Ks + (sr + 64) * KPITCH + sc) = kreg1;
    *(LAS u32x4*)(Vs + sr * VPITCH + sc) = vreg0; *(LAS u32x4*)(Vs + sr * VPITCH + sc + 64) = vreg1;
    __syncthreads();
    f32x16 Oa0, Oa1, Ob0, Ob1;
#pragma unroll
    for (int i = 0; i < 16; ++i) { Oa0[i] = 0.f; Oa1[i] = 0.f; Ob0[i] = 0.f; Ob1[i] = 0.f; }
    float lsa = 0.f, lsb = 0.f;
    for (int t = 0; t < ntile; ++t) {
        const int buf = t & 1;
        if (t + 1 < ntile) { const GAS bf16_t* kq = kgp + (size_t)(t + 1) * 128 * 64; const GAS bf16_t* vq = vgp + (t + 1) * 128;
            kreg0 = *(const GAS u32x4*)kq; kreg1 = *(const GAS u32x4*)(kq + 64 * 64); vreg0 = *(const GAS u32x4*)vq; vreg1 = *(const GAS u32x4*)(vq + 64); }
#define ATT2_QK(KS, SA, SB) do { const LAS bf16_t* _kt = Ks + buf * 128 * KPITCH + (KS) * 32 * KPITCH + l31 * KPITCH + 8 * hi; \
            const bf16x8 _k0 = *(const LAS bf16x8*)(_kt), _k1 = *(const LAS bf16x8*)(_kt + 16), _k2 = *(const LAS bf16x8*)(_kt + 32), _k3 = *(const LAS bf16x8*)(_kt + 48); \
            SA = __builtin_amdgcn_mfma_f32_32x32x16_bf16(_k0, qf[0][0], (f32x16)(0.f), 0, 0, 0); SB = __builtin_amdgcn_mfma_f32_32x32x16_bf16(_k0, qf[1][0], (f32x16)(0.f), 0, 0, 0); \
            SA = __builtin_amdgcn_mfma_f32_32x32x16_bf16(_k1, qf[0][1], SA, 0, 0, 0); SB = __builtin_amdgcn_mfma_f32_32x32x16_bf16(_k1, qf[1][1], SB, 0, 0, 0); \
            SA = __builtin_amdgcn_mfma_f32_32x32x16_bf16(_k2, qf[0][2], SA, 0, 0, 0); SB = __builtin_amdgcn_mfma_f32_32x32x16_bf16(_k2, qf[1][2], SB, 0, 0, 0); \
            SA = __builtin_amdgcn_mfma_f32_32x32x16_bf16(_k3, qf[0][3], SA, 0, 0, 0); SB = __builtin_amdgcn_mfma_f32_32x32x16_bf16(_k3, qf[1][3], SB, 0, 0, 0); } while (0)
        const bool lastt = (t == ntile - 1);
        f32x16 Sa, Sb, San, Sbn;
        ATT2_QK(0, Sa, Sb);
#pragma unroll
        for (int ks = 0; ks < 4; ++ks) {
            if (ks >= 1 && lastt) break;
            if (ks + 1 < 4 && !lastt) ATT2_QK(ks + 1, San, Sbn);
            const LAS bf16_t* vt = Vs + buf * 64 * VPITCH + ks * 32 + l31 * VPITCH + 4 * hi;
            if (t == ntile - 1) { const int nv = L - t * 128 - ks * 32; asm volatile("" : "+v"(Sa), "+v"(Sb));
#pragma unroll
                for (int i = 0; i < 16; ++i) { const int key = (i & 3) + 8 * (i >> 2) + 4 * hi; if (key >= nv) { Sa[i] = -1e30f; Sb[i] = -1e30f; } } }
            float psa = 0.f, psb = 0.f;
#pragma unroll
            for (int i = 0; i < 16; ++i) { Sa[i] = __builtin_amdgcn_exp2f(Sa[i]); Sb[i] = __builtin_amdgcn_exp2f(Sb[i]); psa += Sa[i]; psb += Sb[i]; }
            lsa += psa; lsb += psb;
#pragma unroll
            for (int k2s = 0; k2s < 2; ++k2s) {
                const u32x2 a0l = *(const LAS u32x2*)(vt + 16 * k2s), a0h = *(const LAS u32x2*)(vt + 16 * k2s + 8);
                const u32x2 a1l = *(const LAS u32x2*)(vt + 32 * VPITCH + 16 * k2s), a1h = *(const LAS u32x2*)(vt + 32 * VPITCH + 16 * k2s + 8);
                const bf16x8 va0 = __builtin_bit_cast(bf16x8, (u32x4){a0l.x, a0l.y, a0h.x, a0h.y});
                const bf16x8 va1 = __builtin_bit_cast(bf16x8, (u32x4){a1l.x, a1l.y, a1h.x, a1h.y});
                u32x4 pa, pb;
                pa.x = cvt_pk_bf16(Sa[8 * k2s + 0], Sa[8 * k2s + 1]); pa.y = cvt_pk_bf16(Sa[8 * k2s + 2], Sa[8 * k2s + 3]); pa.z = cvt_pk_bf16(Sa[8 * k2s + 4], Sa[8 * k2s + 5]); pa.w = cvt_pk_bf16(Sa[8 * k2s + 6], Sa[8 * k2s + 7]);
                pb.x = cvt_pk_bf16(Sb[8 * k2s + 0], Sb[8 * k2s + 1]); pb.y = cvt_pk_bf16(Sb[8 * k2s + 2], Sb[8 * k2s + 3]); pb.z = cvt_pk_bf16(Sb[8 * k2s + 4], Sb[8 * k2s + 5]); pb.w = cvt_pk_bf16(Sb[8 * k2s + 6], Sb[8 * k2s + 7]);
                const bf16x8 pfa = __builtin_bit_cast(bf16x8, pa), pfb = __builtin_bit_cast(bf16x8, pb);
                Oa0 = __builtin_amdgcn_mfma_f32_32x32x16_bf16(va0, pfa, Oa0, 0, 0, 0); Ob0 = __builtin_amdgcn_mfma_f32_32x32x16_bf16(va0, pfb, Ob0, 0, 0, 0);
                Oa1 = __builtin_amdgcn_mfma_f32_32x32x16_bf16(va1, pfa, Oa1, 0, 0, 0); Ob1 = __builtin_amdgcn_mfma_f32_32x32x16_bf16(va1, pfb, Ob1, 0, 0, 0);
            }
            if (ks + 1 < 4 && !lastt) { Sa = San; Sb = Sbn; }
        }
#undef ATT2_QK
        if (t + 1 < ntile) { LAS bf16_t* kd = Ks + (buf ^ 1) * 128 * KPITCH; LAS bf16_t* vd = Vs + (buf ^ 1) * 64 * VPITCH;
            *(LAS u32x4*)(kd + sr * KPITCH + sc) = kreg0; *(LAS u32x4*)(kd + (sr + 64) * KPITCH + sc) = kreg1;
            *(LAS u32x4*)(vd + sr * VPITCH + sc) = vreg0; *(LAS u32x4*)(vd + sr * VPITCH + sc + 64) = vreg1; }
        __syncthreads();
    }
    const float inva = 1.f / (lsa + __shfl_xor(lsa, 32)), invb = 1.f / (lsb + __shfl_xor(lsb, 32));
    GAS bf16_t* op = O + (size_t)row * DM + h0 * 64 + 4 * hi;
#pragma unroll
    for (int g4 = 0; g4 < 4; ++g4) {
        u32x2 w0, w1, w2, w3;
        w0.x = cvt_pk_bf16(Oa0[4 * g4] * inva, Oa0[4 * g4 + 1] * inva); w0.y = cvt_pk_bf16(Oa0[4 * g4 + 2] * inva, Oa0[4 * g4 + 3] * inva);
        w1.x = cvt_pk_bf16(Oa1[4 * g4] * inva, Oa1[4 * g4 + 1] * inva); w1.y = cvt_pk_bf16(Oa1[4 * g4 + 2] * inva, Oa1[4 * g4 + 3] * inva);
        w2.x = cvt_pk_bf16(Ob0[4 * g4] * invb, Ob0[4 * g4 + 1] * invb); w2.y = cvt_pk_bf16(Ob0[4 * g4 + 2] * invb, Ob0[4 * g4 + 3] * invb);
        w3.x = cvt_pk_bf16(Ob1[4 * g4] * invb, Ob1[4 * g4 + 1] * invb); w3.y = cvt_pk_bf16(Ob1[4 * g4 + 2] * invb, Ob1[4 * g4 + 3] * invb);
        *(GAS u32x2*)(op + 8 * g4) = w0; *(GAS u32x2*)(op + 32 + 8 * g4) = w1; *(GAS u32x2*)(op + 64 + 8 * g4) = w2; *(GAS u32x2*)(op + 96 + 8 * g4) = w3;
    }
}

constexpr int SP = 136;
__device__ __forceinline__ void chunk_decode(int cgl, int& s, int& c, int& p0, int& nvalid) {
    if (cgl < 129) { s = 0; c = cgl; } else { const int q = cgl - 129; s = 1 + q / 17; c = q % 17; }
    if (c == 0) { p0 = 0; nvalid = 16; } else { p0 = 16 + (c - 1) * 128; nvalid = 128; }
}
__device__ __forceinline__ float xbc_at(const bf16_t* XBC, int s, int L, int pos, int ch) { return (pos >= 0 && pos < L) ? bf2f(XBC[(size_t)pos2row(s, pos) * 1536 + ch]) : 0.f; }
__device__ __forceinline__ f32x16 mma32(const LAS bf16_t* A, const LAS bf16_t* B, f32x16 acc, int lane) {
    const LAS bf16_t* ap = A + (lane & 31) * SP + 8 * (lane >> 5); const LAS bf16_t* bp = B + (lane & 31) * SP + 8 * (lane >> 5);
#pragma unroll
    for (int k0 = 0; k0 < 128; k0 += 16) acc = __builtin_amdgcn_mfma_f32_32x32x16_bf16(*(const LAS bf16x8*)(ap + k0), *(const LAS bf16x8*)(bp + k0), acc, 0, 0, 0);
    return acc;
}
#define CONV_LOAD(V, N, ch, t0) do { \
    _Pragma("unroll") for (int _i = 0; _i < (N) + 4; ++_i) { const int _pos = p0 + (t0) + _i - 2; const int _pc = min(max(_pos, 0), L - 1); \
        const float _x = bf2f(XBC[(unsigned)pos2row(s, _pc) * 1536u + (unsigned)(ch)]); V[_i] = (_pos >= 0 && _pos < L) ? _x : 0.f; } } while (0)
#define CONV_EMIT(V, N, ch, t0, EMIT) do { \
    const float _w0 = cw[(ch)], _w1 = cw[1536 + (ch)], _w2 = cw[2 * 1536 + (ch)], _w3 = cw[3 * 1536 + (ch)], _w4 = cw[4 * 1536 + (ch)], _b = cb[(ch)]; \
    _Pragma("unroll") for (int _i = 0; _i < (N); ++_i) { const int _t = (t0) + _i; \
        float _o = _b + _w0 * V[_i] + _w1 * V[_i + 1] + _w2 * V[_i + 2] + _w3 * V[_i + 3] + _w4 * V[_i + 4]; _o = silu_f(_o); if (_t >= nvalid) _o = 0.f; EMIT; } } while (0)

__device__ __forceinline__ void chunk_cumsum(const float* DT, LAS float* VEC, int s, int p0, int nvalid, int h, float Af, float Ab, int wave, int lane, float* decw  ) {
    if (wave == 0) {
        const int t0 = 2 * lane, t1 = t0 + 1;
        const float d0 = t0 < nvalid ? DT[(size_t)pos2row(s, p0 + t0) * 32 + h] : 0.f, d1 = t1 < nvalid ? DT[(size_t)pos2row(s, p0 + t1) * 32 + h] : 0.f;
        const float a0 = d0 * Af, a1 = d1 * Af, ssum = a0 + a1; float inc = ssum;
#pragma unroll
        for (int o = 1; o < 64; o <<= 1) { const float v = shfl_up_l(inc, o, lane); if (lane >= o) inc += v; }
        const float exc = inc - ssum, tot = shfl_idx_l(inc, 63);
        VEC[t0] = exc + a0; VEC[t1] = inc; VEC[256 + t0] = d0; VEC[256 + t1] = d1;
        if (decw) { VEC[512 + t0] = __expf(tot - (exc + a0)) * d0; VEC[512 + t1] = __expf(tot - inc) * d1; if (lane == 0) decw[0] = __expf(tot); }
        else { VEC[512 + t0] = __expf(exc + a0); VEC[512 + t1] = __expf(inc); }
    } else if (wave == 1) {
        const int t0 = 127 - 2 * lane, t1 = t0 - 1;
        const float d0 = t0 < nvalid ? DT[(size_t)pos2row(s, p0 + t0) * 32 + 16 + h] : 0.f, d1 = t1 < nvalid ? DT[(size_t)pos2row(s, p0 + t1) * 32 + 16 + h] : 0.f;
        const float a0 = d0 * Ab, a1 = d1 * Ab, ssum = a0 + a1; float inc = ssum;
#pragma unroll
        for (int o = 1; o < 64; o <<= 1) { const float v = shfl_up_l(inc, o, lane); if (lane >= o) inc += v; }
        const float exc = inc - ssum, tot = shfl_idx_l(inc, 63);
        VEC[128 + t0] = exc + a0; VEC[128 + t1] = inc; VEC[384 + t0] = d0; VEC[384 + t1] = d1;
        if (decw) { VEC[640 + t0] = __expf(tot - (exc + a0)) * d0; VEC[640 + t1] = __expf(tot - inc) * d1; if (lane == 0) decw[1] = __expf(tot); }
        else { VEC[640 + t0] = __expf(exc + a0); VEC[640 + t1] = __expf(inc); }
    }
}

__device__ __forceinline__ void ssd_states_unit(const Params& p, LAS unsigned char* lds, int unit, int tid, int wave, int lane) {
    const int cgl = unit >> 1, g = unit & 1; int s, c, p0, nvalid; chunk_decode(cgl, s, c, p0, nvalid); const int L = seq_L(s);
    const bf16_t* XBC = (const bf16_t*)(p.ws + OFF_XBC); const float* DT = (const float*)(p.ws + OFF_DT);
    const float* cw = p.in[10]; const float* cb = p.in[11];
    bf16_t* ST = (bf16_t*)(p.ws + OFF_STATES); float* DEC = (float*)(p.ws + OFF_DEC);
    LAS bf16_t* Bt = (LAS bf16_t*)lds;
    LAS bf16_t* Xf = Bt + 128 * SP;
    LAS bf16_t* Xb = Xf + 64 * SP;
    LAS float* VEC = (LAS float*)(Xb + 64 * SP);
    { const int n = tid & 127, tq = tid >> 7, ch = 1024 + g * 128 + n; float vb[20];
#pragma unroll 1
      for (int hf = 0; hf < 2; ++hf) { const int t0 = tq * 32 + hf * 16;
          CONV_LOAD(vb, 16, ch, t0);
          CONV_EMIT(vb, 16, ch, t0, Bt[n * SP + _t] = (bf16_t)f2bf(_o)); } }
    for (int hh = 0; hh < 8; ++hh) {
        const int h = g * 8 + hh;
        const float Af = -__expf(p.in[12][h]), Ab = -__expf(p.in[12][16 + h]);
        asm volatile("" : "+s"(p0));
        const int pp = tid & 63, tq = tid >> 6, ch = h * 64 + pp; float vx[20];
        CONV_LOAD(vx, 16, ch, tq * 16);
        chunk_cumsum(DT, VEC, s, p0, nvalid, h, Af, Ab, wave, lane, DEC + ((size_t)cgl * 16 + h) * 2);
        __syncthreads();
        CONV_EMIT(vx, 16, ch, tq * 16, { Xf[pp * SP + _t] = (bf16_t)f2bf(_o * VEC[512 + _t]); Xb[pp * SP + _t] = (bf16_t)f2bf(_o * VEC[640 + _t]); });
        __syncthreads();
        { const int tn = wave & 3, tp = wave >> 2;
          f32x16 af, ab;
#pragma unroll
          for (int i = 0; i < 16; ++i) { af[i] = 0.f; ab[i] = 0.f; }
          af = mma32(Bt + tn * 32 * SP, Xf + tp * 32 * SP, af, lane);
          ab = mma32(Bt + tn * 32 * SP, Xb + tp * 32 * SP, ab, lane);
          const int pcol = tp * 32 + (lane & 31), hi = lane >> 5;
          bf16_t* sf = ST + (((size_t)cgl * 16 + h) * 2) * 8192 + (size_t)pcol * 128 + tn * 32 + 4 * hi;
#pragma unroll
          for (int g4 = 0; g4 < 4; ++g4) {
              u32x2 w0, w1;
              w0.x = cvt_pk_bf16(af[4 * g4], af[4 * g4 + 1]); w0.y = cvt_pk_bf16(af[4 * g4 + 2], af[4 * g4 + 3]);
              w1.x = cvt_pk_bf16(ab[4 * g4], ab[4 * g4 + 1]); w1.y = cvt_pk_bf16(ab[4 * g4 + 2], ab[4 * g4 + 3]);
              *(u32x2*)(sf + 8 * g4) = w0; *(u32x2*)(sf + 8192 + 8 * g4) = w1;
          } }
        __syncthreads();
    }
}

__device__ __forceinline__ void ssd_scan_phase(const Params& p, int wave, int lane) {
    bf16_t* ST = (bf16_t*)(p.ws + OFF_STATES); const float* DEC = (const float*)(p.ws + OFF_DEC);
    for (int k = 0;; ++k) {
        const int wi = (blockIdx.x + gridDim.x * wave) + gridDim.x * 8 * k;
        if (wi >= 4608) break;
        int s, q; if (wi < 512) { s = 0; q = wi; } else { s = 1 + (wi - 512) / 512; q = (wi - 512) % 512; }
        const int hd = q >> 4, h = hd >> 1, dir = hd & 1, e = ((q & 15) * 64 + lane) * 8;
        const int nch = s == 0 ? 129 : 17, cb0 = s == 0 ? 0 : 129 + (s - 1) * 17;
        float carry[8];
#pragma unroll
        for (int i = 0; i < 8; ++i) carry[i] = 0.f;
        const size_t cstride = (size_t)16 * 2 * 8192;
        bf16_t* base = ST + (((size_t)cb0 * 16 + h) * 2 + dir) * 8192 + e;
        const float* dbase = DEC + ((size_t)cb0 * 16 + h) * 2 + dir;
        for (int j0 = 0; j0 < nch; j0 += 8) {
            u32x4 v[8]; float d[8];
#pragma unroll
            for (int jj = 0; jj < 8; ++jj) { const int j = min(j0 + jj, nch - 1), c = dir == 0 ? j : nch - 1 - j;
                v[jj] = __builtin_nontemporal_load((const u32x4*)(base + (size_t)c * cstride)); d[jj] = dbase[(size_t)c * 32]; }
#pragma unroll
            for (int jj = 0; jj < 8; ++jj) { if (j0 + jj < nch) { const int j = j0 + jj, c = dir == 0 ? j : nch - 1 - j;
                u32x4 o; o.x = pk2(carry[0], carry[1]); o.y = pk2(carry[2], carry[3]); o.z = pk2(carry[4], carry[5]); o.w = pk2(carry[6], carry[7]);
                *(u32x4*)(base + (size_t)c * cstride) = o;
                const float dd = d[jj]; const u32x4 vv = v[jj];
                carry[0] = carry[0] * dd + bflo(vv.x); carry[1] = carry[1] * dd + bfhi(vv.x); carry[2] = carry[2] * dd + bflo(vv.y); carry[3] = carry[3] * dd + bfhi(vv.y);
                carry[4] = carry[4] * dd + bflo(vv.z); carry[5] = carry[5] * dd + bfhi(vv.z); carry[6] = carry[6] * dd + bflo(vv.w); carry[7] = carry[7] * dd + bfhi(vv.w); } }
        }
    }
}

__device__ __forceinline__ void ssd_out_unit(const Params& p, LAS unsigned char* lds, int unit, int tid, int wave, int lane) {
    const int cgl = unit >> 1, g = unit & 1; int s, c, p0, nvalid; chunk_decode(cgl, s, c, p0, nvalid); const int L = seq_L(s);
    const bf16_t* XBC = (const bf16_t*)(p.ws + OFF_XBC); const float* DT = (const float*)(p.ws + OFF_DT); const bf16_t* Z = (const bf16_t*)(p.ws + OFF_Z);
    const float* cw = p.in[10]; const float* cb = p.in[11];
    const bf16_t* ST = (const bf16_t*)(p.ws + OFF_STATES);
    bf16_t* MIX = (bf16_t*)(p.ws + OFF_B);
    LAS bf16_t* Cs = (LAS bf16_t*)lds;
    LAS bf16_t* BG = Cs + 128 * SP;
    LAS bf16_t* Xt = BG + 128 * SP;
    LAS bf16_t* Pf = Xt + 64 * SP;
    LAS bf16_t* Pb = Pf + 64 * SP;
    LAS float* VEC = (LAS float*)(Pb + 64 * SP);
    LAS float* RSS = VEC + 768;
    const int hi = lane >> 5, l31 = lane & 31;
    int rowbase = c == 0 ? NTOKR + 16 * s : seq_base(s) + (c - 1) * 128;
    { const int n = tid & 127, tq = tid >> 7, chB = 1024 + g * 128 + n, chC = 1280 + g * 128 + n; float vb[20], vc[20];
#pragma unroll 1
      for (int hf = 0; hf < 2; ++hf) { const int t0 = tq * 32 + hf * 16;
          CONV_LOAD(vb, 16, chB, t0); CONV_LOAD(vc, 16, chC, t0);
          CONV_EMIT(vb, 16, chB, t0, BG[_t * SP + n] = (bf16_t)f2bf(_o));
          CONV_EMIT(vc, 16, chC, t0, Cs[_t * SP + n] = (bf16_t)f2bf(_o)); } }
    if (tid < 128) RSS[tid] = 0.f;
    __syncthreads();
    const int ts = wave & 3, ttb = 2 * (wave >> 2);
    f32x16 cbt0, cbt1;
#pragma unroll
    for (int i = 0; i < 16; ++i) { cbt0[i] = 0.f; cbt1[i] = 0.f; }
    cbt0 = mma32(BG + ts * 32 * SP, Cs + ttb * 32 * SP, cbt0, lane);
    cbt1 = mma32(BG + ts * 32 * SP, Cs + (ttb + 1) * 32 * SP, cbt1, lane);
    __syncthreads();
    float qacc[16];
#pragma unroll
    for (int i = 0; i < 16; ++i) qacc[i] = 0.f;
    for (int hh = 0; hh < 8; ++hh) {
        const int h = g * 8 + hh;
        const float Af = -__expf(p.in[12][h]), Ab = -__expf(p.in[12][16 + h]), Dh = p.in[14][h];
        asm volatile("" : "+s"(p0)); asm volatile("" : "+s"(rowbase));
        int lane_h = lane; asm volatile("" : "+v"(lane_h)); const int hi = lane_h >> 5, l31 = lane_h & 31;
        int tid_h = tid; asm volatile("" : "+v"(tid_h));
        const int cpp = tid_h & 63, ctq = tid_h >> 6, cch = h * 64 + cpp; float vx[20];
        CONV_LOAD(vx, 16, cch, ctq * 16);
        const bf16_t* sf = ST + (((size_t)cgl * 16 + h) * 2) * 8192;
        const u32x4 pf0 = __builtin_nontemporal_load((const u32x4*)(sf + tid_h * 8)), pf1 = __builtin_nontemporal_load((const u32x4*)(sf + (tid_h + 512) * 8)), pb0 = __builtin_nontemporal_load((const u32x4*)(sf + 8192 + tid_h * 8)), pb1 = __builtin_nontemporal_load((const u32x4*)(sf + 8192 + (tid_h + 512) * 8));
        bf16_t zr[16];
        { const int tt = wave & 3, tp = wave >> 2; const unsigned zb = (unsigned)rowbase * 1024u + (unsigned)(h * 64 + tp * 32 + l31);
#pragma unroll
          for (int i = 0; i < 16; ++i) { const int t = min(tt * 32 + (i & 3) + 8 * (i >> 2) + 4 * hi, nvalid - 1); zr[i] = Z[zb + (unsigned)t * 1024u]; } }
        chunk_cumsum(DT, VEC, s, p0, nvalid, h, Af, Ab, wave, lane_h, nullptr);
        CONV_EMIT(vx, 16, cch, ctq * 16, Xt[cpp * SP + _t] = (bf16_t)f2bf(_o));
        { const int e0 = tid_h * 8, e1 = (tid_h + 512) * 8;
          *(LAS u32x4*)(Pf + (e0 >> 7) * SP + (e0 & 127)) = pf0; *(LAS u32x4*)(Pf + (e1 >> 7) * SP + (e1 & 127)) = pf1;
          *(LAS u32x4*)(Pb + (e0 >> 7) * SP + (e0 & 127)) = pb0; *(LAS u32x4*)(Pb + (e1 >> 7) * SP + (e1 & 127)) = pb1; }
        __syncthreads();
#pragma unroll
        for (int j = 0; j < 2; ++j) {
            const int tt = ttb + j, tc = tt * 32 + l31; const float at = VEC[tc], rt = VEC[128 + tc];
            LAS bf16_t* gp = BG + tc * SP + ts * 32 + 4 * hi;
            if (ts < tt) {
#pragma unroll
                for (int g4 = 0; g4 < 4; ++g4) { float gv[4];
#pragma unroll
                    for (int i = 0; i < 4; ++i) { const int sr = ts * 32 + 8 * g4 + 4 * hi + i; const float cb = j == 0 ? cbt0[4 * g4 + i] : cbt1[4 * g4 + i];
                        gv[i] = cb * (__expf(at - VEC[sr]) * VEC[256 + sr]); }
                    u32x2 w; w.x = cvt_pk_bf16(gv[0], gv[1]); w.y = cvt_pk_bf16(gv[2], gv[3]); *(LAS u32x2*)(gp + 8 * g4) = w; }
            } else if (ts > tt) {
#pragma unroll
                for (int g4 = 0; g4 < 4; ++g4) { float gv[4];
#pragma unroll
                    for (int i = 0; i < 4; ++i) { const int sr = ts * 32 + 8 * g4 + 4 * hi + i; const float cb = j == 0 ? cbt0[4 * g4 + i] : cbt1[4 * g4 + i];
                        gv[i] = cb * (__expf(rt - VEC[128 + sr]) * VEC[384 + sr]); }
                    u32x2 w; w.x = cvt_pk_bf16(gv[0], gv[1]); w.y = cvt_pk_bf16(gv[2], gv[3]); *(LAS u32x2*)(gp + 8 * g4) = w; }
            } else {
#pragma unroll
                for (int g4 = 0; g4 < 4; ++g4) { float gv[4];
#pragma unroll
                    for (int i = 0; i < 4; ++i) { const int sr = ts * 32 + 8 * g4 + 4 * hi + i; const float cb = j == 0 ? cbt0[4 * g4 + i] : cbt1[4 * g4 + i];
                        const float lf = sr <= tc ? __expf(at - VEC[sr]) * VEC[256 + sr] : 0.f, lb = sr >= tc ? __expf(rt - VEC[128 + sr]) * VEC[384 + sr] : 0.f;
                        gv[i] = cb * (lf + lb); }
                    u32x2 w; w.x = cvt_pk_bf16(gv[0], gv[1]); w.y = cvt_pk_bf16(gv[2], gv[3]); *(LAS u32x2*)(gp + 8 * g4) = w; }
            }
        }
        __syncthreads();
        { const int tt = wave & 3, tp = wave >> 2;
          f32x16 yd, yf, yb;
#pragma unroll
          for (int i = 0; i < 16; ++i) { yd[i] = 0.f; yf[i] = 0.f; yb[i] = 0.f; }
          yd = mma32(BG + tt * 32 * SP, Xt + tp * 32 * SP, yd, lane);
          yf = mma32(Cs + tt * 32 * SP, Pf + tp * 32 * SP, yf, lane);
          yb = mma32(Cs + tt * 32 * SP, Pb + tp * 32 * SP, yb, lane);
          const int pcol = tp * 32 + l31;
          const unsigned mbase = (unsigned)rowbase * 2048u + 1024u + (unsigned)(h * 64 + pcol);
#pragma unroll
          for (int i = 0; i < 16; ++i) {
              const int t = tt * 32 + (i & 3) + 8 * (i >> 2) + 4 * hi;
              if (t < nvalid) {
                  float y = yd[i] + VEC[512 + t] * yf[i] + VEC[640 + t] * yb[i] + Dh * bf2f(Xt[pcol * SP + t]);
                  const float z = bf2f(zr[i]);
                  y *= silu_f(z);
                  MIX[(size_t)(mbase + (unsigned)t * 2048u)] = (bf16_t)f2bf(y);
                  qacc[i] += y * y;
              }
              if ((i & 3) == 3) __builtin_amdgcn_sched_barrier(0);
          } }
        __syncthreads();
    }
    { const int tt = wave & 3, hi2 = lane >> 5;
#pragma unroll
      for (int i = 0; i < 16; ++i) { float q = qacc[i];
          q += __shfl_xor(q, 1); q += __shfl_xor(q, 2); q += __shfl_xor(q, 4); q += __shfl_xor(q, 8); q += __shfl_xor(q, 16);
          const int t = tt * 32 + (i & 3) + 8 * (i >> 2) + 4 * hi2;
          if ((lane & 31) == 0) atomicAdd((float*)(RSS + t), q); } }
    __syncthreads();
    __syncthreads();
    {
      const float* ng = p.in[17] + g * 512;
#pragma unroll 4
      for (int k = 0; k < 16; ++k) { const int idx = tid + 512 * k, row = idx >> 6, c = (idx & 63) * 8;
          if (row < nvalid) { const float rs = rsqrtf(RSS[row] * (1.f / 512.f) + EPS);
              u32x4* mp = (u32x4*)(MIX + (size_t)(rowbase + row) * DM + 1024 + g * 512 + c); const u32x4 v = *mp;
              const f32x4 g0 = *(const f32x4*)(ng + c), g1 = *(const f32x4*)(ng + c + 4);
              u32x4 o; o.x = pk2(bflo(v.x) * rs * g0.x, bfhi(v.x) * rs * g0.y); o.y = pk2(bflo(v.y) * rs * g0.z, bfhi(v.y) * rs * g0.w);
              o.z = pk2(bflo(v.z) * rs * g1.x, bfhi(v.z) * rs * g1.y); o.w = pk2(bflo(v.w) * rs * g1.z, bfhi(v.w) * rs * g1.w);
              *mp = o; } } }
    __syncthreads();
}

#define XB_TMO      128
#define XB_XCNT(j)  (256  + 64 * (j))
#define XB_XSUB(j)  (1280 + 64 * (j))
#define XB_XGEN(j)  (2304 + 64 * (j))
#define XB_TOP      3328
#define XB_TOPGEN   3392
#define XCD_BAR_WORDS 3456
#define XB_SPIN_CAP (1u << 22)
__device__ __forceinline__ unsigned xb_ld(unsigned* p)              { return __hip_atomic_load(p, __ATOMIC_RELAXED, __HIP_MEMORY_SCOPE_AGENT); }
__device__ __forceinline__ unsigned xb_add(unsigned* p, unsigned v) { return __hip_atomic_fetch_add(p, v, __ATOMIC_RELAXED, __HIP_MEMORY_SCOPE_AGENT); }
__device__ __forceinline__ unsigned xb_xcc_id() { return (unsigned)__builtin_amdgcn_s_getreg((3 << 11) | 20) & 0xFu; }
#define XB_SPIN(cond, bar) do { unsigned _sp = 0; while (cond) { __builtin_amdgcn_s_sleep(1); \
    if ((++_sp & 255u) == 0u) { if (xb_ld(&(bar)[XB_TMO])) break; if (_sp > XB_SPIN_CAP) { atomicAdd(&(bar)[XB_TMO], 1u); break; } } } } while (0)
struct XcdBarrier { unsigned* bar; unsigned x; volatile LAS unsigned* st; };
__device__ __forceinline__ XcdBarrier xcd_barrier_post(unsigned* bar, volatile LAS unsigned* st) {
    XcdBarrier b; b.bar = bar; b.x = xb_xcc_id(); b.st = st;
    if (threadIdx.x == 0) (void)xb_add(&bar[XB_XCNT(b.x)], 1u);
    return b;
}
__device__ __forceinline__ void xcd_barrier_complete(unsigned* bar, unsigned x, unsigned& nloc, unsigned& nx) {
    const unsigned G = gridDim.x * gridDim.y * gridDim.z;
    unsigned sum, cnt, mine, sp = 0u;
    for (;;) {
        sum = 0u; cnt = 0u; mine = 0u;
#pragma unroll
        for (unsigned j = 0; j < 16; ++j) { const unsigned c = xb_ld(&bar[XB_XCNT(j)]); sum += c; cnt += (c > 0u) ? 1u : 0u; mine = (j == x) ? c : mine; }
        if (sum == G) break;
        __builtin_amdgcn_s_sleep(1);
        if ((++sp & 255u) == 0u) { if (xb_ld(&bar[XB_TMO])) break; if (sp > XB_SPIN_CAP) { atomicAdd(&bar[XB_TMO], 1u); break; } }
    }
    nloc = mine > 0u ? mine : 1u; nx = cnt > 0u ? cnt : 1u;
}
__device__ __forceinline__ void xcd_barrier(const XcdBarrier& b, const int tid) {
    asm volatile("s_waitcnt vmcnt(0)" ::: "memory");
    __syncthreads();
    if (tid == 0) {
        unsigned* bar = b.bar;
        __builtin_amdgcn_s_waitcnt(0);
        unsigned nloc = b.st[0], nx = b.st[1];
        if (nloc == 0u) { xcd_barrier_complete(bar, b.x, nloc, nx); b.st[0] = nloc; b.st[1] = nx; }
        const unsigned old = xb_add(&bar[XB_XSUB(b.x)], 1u);
        const unsigned gen = old / nloc;
        if (old + 1u == (gen + 1u) * nloc) {
            __builtin_amdgcn_fence(__ATOMIC_RELEASE, "agent");
            asm volatile("s_waitcnt vmcnt(0)" ::: "memory");
            const unsigned og = xb_add(&bar[XB_TOP], 1u);
            const unsigned tg = og / nx;
            if (og + 1u == (tg + 1u) * nx) xb_add(&bar[XB_TOPGEN], 1u);
            else XB_SPIN(xb_ld(&bar[XB_TOPGEN]) == tg, bar);
            __builtin_amdgcn_fence(__ATOMIC_ACQUIRE, "agent");
            xb_add(&bar[XB_XGEN(b.x)], 1u);
            asm volatile("s_waitcnt vmcnt(0)" ::: "memory");
        } else {
            XB_SPIN(xb_ld(&bar[XB_XGEN(b.x)]) == gen, bar);
            __builtin_amdgcn_fence(__ATOMIC_ACQUIRE, "agent");
            asm volatile("s_waitcnt vmcnt(0)" ::: "memory");
        }
    }
    __syncthreads();
}

__global__ void __launch_bounds__(512, 2) fwd_kernel(Params p) {
    extern __shared__ __attribute__((aligned(16))) unsigned char lds_raw[];
    cg::grid_group grid = cg::this_grid();
    LAS unsigned char* lds = (LAS unsigned char*)lds_raw;
    const int G = gridDim.x;
    const int wave_s = __builtin_amdgcn_readfirstlane((int)threadIdx.x >> 6);
    int ph = 0;
    { volatile LAS unsigned* st0 = (volatile LAS unsigned*)(lds + MISC_LDS) + 8; if (threadIdx.x < 2) st0[threadIdx.x] = 0u; }
    __syncthreads();
    const XcdBarrier xbar = xcd_barrier_post((unsigned*)(p.ws + OFF_BAR), (volatile LAS unsigned*)(lds + MISC_LDS) + 8);
    if (p.ph_hi < 0) grid.sync();
#define PH_BEGIN if (p.ph_lo <= ph && ph < p.ph_hi) { int wv_ = wave_s; asm volatile("" : "+s"(wv_)); int tid = (wv_ << 6) + (int)__builtin_amdgcn_mbcnt_hi(~0u, __builtin_amdgcn_mbcnt_lo(~0u, 0u)); asm volatile("" : "+v"(tid)); const int lane = tid & 63, wave = __builtin_amdgcn_readfirstlane(tid >> 6); \
        const int gw = blockIdx.x * 8 + wave, NGW = G * 8; unsigned char* ws = p.ws; asm volatile("" : "+s"(ws)); ws = (unsigned char*)(GAS unsigned char*)ws; unsigned* CTL = (unsigned*)(ws + OFF_CTL); bf16_t* Breg = (bf16_t*)(ws + OFF_B); \
        (void)lane; (void)gw; (void)NGW; (void)CTL; (void)Breg;
#define PH_END if (ph + 1 < p.ph_hi) xcd_barrier(xbar, tid); } ++ph;

    PH_BEGIN
        if (blockIdx.x == 0 && tid < 16) CTL[tid] = 0u;
        LAS float* scr = (LAS float*)(lds + wave * 16384);
        convert_ffn(p.in[4], p.in[5], p.in[6], (bf16_t*)(ws + OFF_GU1), (bf16_t*)(ws + OFF_DN1), scr, gw, NGW, lane);
        for (int it = gw; it < 32 * 129; it += NGW) { const int kb = it / 129, nb = it % 129; transpose_item(p.in[9], DM, 4128, (bf16_t*)(ws + OFF_WIN), nb * 32, kb * 64, nb * 32, scr, lane); }
        for (int it = gw; it < 32 * 64; it += NGW) { const int kb = it / 64, nb = it % 64; transpose_item(p.in[18], DM, DM, (bf16_t*)(ws + OFF_WOUT), nb * 32, kb * 64, nb * 32, scr, lane); }
        { u32x4* zp = (u32x4*)(ws + OFF_WIN + (size_t)4128 * DM * 2); const int nz = (NINP - 4128) * DM * 2 / 16;
          for (int i = blockIdx.x * 512 + tid; i < nz; i += G * 512) zp[i] = (u32x4){0u, 0u, 0u, 0u}; }
        row_pass<0>(p, wave, lane, nullptr, p.in[3], nullptr, Breg, 0.f, 0);
    PH_END

    { constexpr int step = 0;
        for (int half = 0; half < 2; ++half) {
            const int row0 = half * 16384, Mh = half == 0 ? 16384 : 16640;
            PH_BEGIN
                pg8::Gemm g{Breg + (size_t)row0 * DM, (const bf16_t*)(ws + (step == 0 ? OFF_GU1 : OFF_GU2)), Mh, 2 * FF, DM}; pg8::StaticOrder S; S.init(Mh, 2 * FF, G, (int)blockIdx.x);
                pg8::EpiSwiglu E{(bf16_t*)(ws + OFF_HID)};
                pg8::gemm_phase<pg8::EpiSwiglu>(lds, g, S, E, tid);
                if (half == 1) { if (step == 0) row_pass_chunks<1>(p, (LAS int*)(lds + MISC_LDS), CTL + 6, 2, tid, wave, lane, p.in[7], p.in[8], Breg, Breg, 0.5f);
                                 else row_pass_chunks<3>(p, (LAS int*)(lds + MISC_LDS), CTL + 7, 2, tid, wave, lane, p.in[24], nullptr, Breg, nullptr, 0.5f); }
            PH_END
            PH_BEGIN
                pg8::Gemm g{(const bf16_t*)(ws + OFF_HID), (const bf16_t*)(ws + (step == 0 ? OFF_DN1 : OFF_DN2)), 16384, DM, FF}; pg8::StaticOrder S; S.init(16384, DM, G, (int)blockIdx.x);
                pg8::EpiStore E{Breg + (size_t)row0 * DM, DM};
                pg8::gemm_phase<pg8::EpiStore>(lds, g, S, E, tid);
                if (half == 1) { if (step == 0) row_pass_chunks<1>(p, (LAS int*)(lds + MISC_LDS), CTL + 6, 1 << 30, tid, wave, lane, p.in[7], p.in[8], Breg, Breg, 0.5f);
                                 else row_pass_chunks<3>(p, (LAS int*)(lds + MISC_LDS), CTL + 7, 1 << 30, tid, wave, lane, p.in[24], nullptr, Breg, nullptr, 0.5f); }
            PH_END
        }
    }
    {
            PH_BEGIN
                { pg8::Gemm g{(const bf16_t*)(ws + OFF_HID) + (size_t)16384 * FF, (const bf16_t*)(ws + OFF_DN1), 256, DM, FF}; pg8::StaticOrder S; S.init(256, DM, G, (int)blockIdx.x);
                  pg8::EpiStore E{Breg + (size_t)NTOKR * DM, DM};
                  pg8::gemm_phase<pg8::EpiStore>(lds, g, S, E, tid); }
                row_pass_chunks<1>(p, (LAS int*)(lds + MISC_LDS), CTL + 6, 1 << 30, tid, wave, lane, p.in[7], p.in[8], Breg, Breg, 0.5f);
                row_pass_chunks<1>(p, (LAS int*)(lds + MISC_LDS), CTL + 9, 1 << 30, tid, wave, lane, p.in[7], p.in[8], Breg, Breg, 0.5f, RP_CHUNKS);
            PH_END
            PH_BEGIN
                row_pass<1>(p, wave, lane, p.in[7], p.in[8], Breg, Breg, 0.5f, NTOKR);
            PH_END
            PH_BEGIN
                pg8::Gemm g{Breg, (const bf16_t*)(ws + OFF_WIN), ROWSP, NINP, DM}; pg8::StaticOrder S; S.init(ROWSP, NINP, G, (int)blockIdx.x);
                pg8::EpiInproj E{(bf16_t*)(ws + OFF_Q), (bf16_t*)(ws + OFF_KP), (bf16_t*)(ws + OFF_VT), (bf16_t*)(ws + OFF_Z), (bf16_t*)(ws + OFF_XBC), (float*)(ws + OFF_DT), p.in[13]};
                pg8::gemm_phase<pg8::EpiInproj>(lds, g, S, E, tid);
            PH_END
            PH_BEGIN
                LAS int* MISC = (LAS int*)(lds + MISC_LDS);
                prep_pads(p, tid);
                for (;;) {
                    if (tid == 0) MISC[0] = (int)atomicAdd(CTL + 1, 1u);
                    __syncthreads();
                    const int u = __builtin_amdgcn_readfirstlane(MISC[0]);
                    __syncthreads();
                    if (u >= NCHUNK * 2 + PREP_NCHUNK) break;
                    if (u < NCHUNK * 2) ssd_states_unit(p, lds, u, tid, wave, lane); else prep_rows(p, u - NCHUNK * 2, wave, lane);
                }
            PH_END
            PH_BEGIN
                ssd_scan_phase(p, wave, lane);
            PH_END
            PH_BEGIN
                LAS int* MISC = (LAS int*)(lds + MISC_LDS);
                constexpr int Q1 = ATT_BIG, Q3 = Q1 + 512, Q4 = Q3 + 512;
                bool fast0;
                { float mq = fabsf(p.in[15][lane]), mk = fabsf(p.in[16][lane]);
#pragma unroll
                  for (int o = 1; o < 64; o <<= 1) { mq = fmaxf(mq, __shfl_xor(mq, o)); mk = fmaxf(mk, __shfl_xor(mk, o)); }
                  const float bound = 8.f * 1.4426950408889634f * mq * mk;
                  fast0 = __builtin_amdgcn_readfirstlane((int)(bound < 60.f)) != 0; }
                int fast_i = fast0 ? 1 : 0;
                for (;;) {
                    unsigned char* wsl = ws; asm volatile("" : "+s"(wsl)); wsl = (unsigned char*)(GAS unsigned char*)wsl;
                    int tidl = tid; asm volatile("" : "+v"(tidl)); const int lanel = tidl & 63;
                    if (tidl == 0) MISC[0] = (int)atomicAdd((unsigned*)(wsl + OFF_CTL) + 3, 1u);
                    __syncthreads();
                    const int u = __builtin_amdgcn_readfirstlane(MISC[0]);
                    __syncthreads();
                    if (u >= Q4) break;
                    asm volatile("" : "+s"(fast_i));
                    if (u < Q1) { if (fast_i) attn_unit2f(wsl, lds, 0, u >> 7, (u & 127) >> 1, u & 1, tidl, wave, lanel); else attn_unit2(wsl, lds, 0, u >> 7, (u & 127) >> 1, u & 1, tidl, wave, lanel, 0); }
                    else if (u < Q3) { const int j = u - Q1, jj = j >> 1; const int cgl = jj < 128 ? 1 + jj : 129 + 17 * ((jj - 128) >> 4) + 1 + ((jj - 128) & 15);
                        ssd_out_unit(p, lds, cgl * 2 + (j & 1), tidl, wave, lanel); }
                    else { const int v = u - Q3; if (fast_i) attn_unit2f(wsl, lds, 1 + (v >> 6), (v >> 4) & 3, (v >> 1) & 7, v & 1, tidl, wave, lanel); else attn_unit2(wsl, lds, 1 + (v >> 6), (v >> 4) & 3, (v >> 1) & 7, v & 1, tidl, wave, lanel, 0); }
                }
            PH_END
            PH_BEGIN
                pg8::Gemm g{Breg, (const bf16_t*)(ws + OFF_WOUT), NTOKR, DM, DM}; pg8::StaticOrder S; S.init(NTOKR, DM, G, (int)blockIdx.x);
                pg8::EpiStore E{(bf16_t*)(ws + OFF_MO), DM};
                pg8::gemm_phase<pg8::EpiStore>(lds, g, S, E, tid);
                convert_ffn_dyn(p.in[21], p.in[22], p.in[23], (bf16_t*)(ws + OFF_GU2), (bf16_t*)(ws + OFF_DN2), lds, CTL + 8, 3, tid, wave, lane);
            PH_END
            PH_BEGIN
                convert_ffn_dyn(p.in[21], p.in[22], p.in[23], (bf16_t*)(ws + OFF_GU2), (bf16_t*)(ws + OFF_DN2), lds, CTL + 8, 1 << 30, tid, wave, lane);
                row_pass<2>(p, wave, lane, p.in[19], p.in[20], (const bf16_t*)(ws + OFF_MO), Breg, 1.0f, 0);
            PH_END
    }
    { constexpr int step = 1;
        for (int half = 0; half < 2; ++half) {
            const int row0 = half * 16384, Mh = 16384;
            PH_BEGIN
                pg8::Gemm g{Breg + (size_t)row0 * DM, (const bf16_t*)(ws + (step == 0 ? OFF_GU1 : OFF_GU2)), Mh, 2 * FF, DM}; pg8::StaticOrder S; S.init(Mh, 2 * FF, G, (int)blockIdx.x);
                pg8::EpiSwiglu E{(bf16_t*)(ws + OFF_HID)};
                pg8::gemm_phase<pg8::EpiSwiglu>(lds, g, S, E, tid);
                if (half == 1) { if (step == 0) row_pass_chunks<1>(p, (LAS int*)(lds + MISC_LDS), CTL + 6, 2, tid, wave, lane, p.in[7], p.in[8], Breg, Breg, 0.5f);
                                 else row_pass_chunks<3>(p, (LAS int*)(lds + MISC_LDS), CTL + 7, 2, tid, wave, lane, p.in[24], nullptr, Breg, nullptr, 0.5f); }
            PH_END
            PH_BEGIN
                pg8::Gemm g{(const bf16_t*)(ws + OFF_HID), (const bf16_t*)(ws + (step == 0 ? OFF_DN1 : OFF_DN2)), Mh, DM, FF}; pg8::StaticOrder S; S.init(Mh, DM, G, (int)blockIdx.x);
                pg8::EpiStore E{Breg + (size_t)row0 * DM, DM};
                pg8::gemm_phase<pg8::EpiStore>(lds, g, S, E, tid);
                if (half == 1) { if (step == 0) row_pass_chunks<1>(p, (LAS int*)(lds + MISC_LDS), CTL + 6, 1 << 30, tid, wave, lane, p.in[7], p.in[8], Breg, Breg, 0.5f);
                                 else row_pass_chunks<3>(p, (LAS int*)(lds + MISC_LDS), CTL + 7, 1 << 30, tid, wave, lane, p.in[24], nullptr, Breg, nullptr, 0.5f); }
            PH_END
        }
    }
    {
            PH_BEGIN
                row_pass_chunks<3>(p, (LAS int*)(lds + MISC_LDS), CTL + 7, 1 << 30, tid, wave, lane, p.in[24], nullptr, Breg, nullptr, 0.5f);
                row_pass<3>(p, wave, lane, p.in[24], nullptr, Breg, nullptr, 0.5f, 16384);
            PH_END
    }
#undef PH_BEGIN
#undef PH_END
}

extern "C" void kernel_launch(void* const* d_in, const int* in_sizes, int n_in, void* d_out, int out_size, void* d_ws, size_t ws_size, hipStream_t stream) {
    static int grid_blocks = 0;
    if (grid_blocks == 0) {
        if (n_in != 25 || ws_size < OFF_END) { fprintf(stderr, "kernel_launch: unexpected n_in %d / ws_size %zu (need %zu)\n", n_in, ws_size, (size_t)OFF_END); grid_blocks = -1; return; }
        int dev = 0, cus = 0, per_cu = 0;
        hipGetDevice(&dev);
        hipDeviceGetAttribute(&cus, hipDeviceAttributeMultiprocessorCount, dev);
        if (hipFuncSetAttribute((const void*)fwd_kernel, hipFuncAttributeMaxDynamicSharedMemorySize, LDS_BYTES) != hipSuccess) fprintf(stderr, "kernel_launch: hipFuncSetAttribute failed\n");
        if (hipOccupancyMaxActiveBlocksPerMultiprocessor(&per_cu, (const void*)fwd_kernel, 512, LDS_BYTES) != hipSuccess || per_cu < 1) per_cu = 1;
        (void)hipGetLastError();
        if (per_cu > 1) per_cu = 1;
        grid_blocks = cus * per_cu;
    }
    if (grid_blocks < 0) return;
    Params p{};
    for (int i = 0; i < 25; ++i) p.in[i] = (const float*)d_in[i];
    p.out = (float*)d_out; p.ws = (unsigned char*)d_ws; p.ph_lo = 0; p.ph_hi = 1000;
    if (hipMemsetAsync((unsigned char*)d_ws + OFF_BAR, 0, (size_t)XCD_BAR_WORDS * 4, stream) != hipSuccess) { fprintf(stderr, "kernel_launch: memset of the barrier words failed\n"); return; }
    void* args[] = {&p};
    hipError_t e = hipLaunchCooperativeKernel((const void*)fwd_kernel, dim3(grid_blocks), dim3(512), args, LDS_BYTES, stream);
    if (e != hipSuccess) fprintf(stderr, "cooperative launch failed: %s (grid %d)\n", hipGetErrorString(e), grid_blocks);
}
```
